# Optimizing an MI355X kernel written in HIP

```python
import math
import jax, jax.numpy as jnp
from jax import lax
import numpy as np

D_MODEL = 1024
BATCH = 8
SEQ = 4096
DEPTH = 2

GRID_W = 64
CTX_LEN = 256
N_MIXERS = 2
EPS = 1e-6
S5_GC = 16
S5_G = D_MODEL // S5_GC
S5_P = 64
MLA_H = 16
MLA_NOPE = 64
MLA_ROPE = 32
MLA_V = 64
MLA_QL = D_MODEL // 2
MLA_KVL = D_MODEL // 4
MLA_QK = MLA_NOPE + MLA_ROPE
ROPE_BASE = 10000.0
Q_BLOCK = 128
FFN_HIDDEN = ((8 * D_MODEL + 3 * 256 - 1) // (3 * 256)) * 256

kernel_name = 'hybrid_s5_mla_adaln_prefix_trunk'


def rmsnorm(x, g):
    xf = x.astype(jnp.float32)
    y = xf * lax.rsqrt(jnp.mean(xf * xf, axis=-1, keepdims=True) + EPS)
    return (y * g.astype(jnp.float32)).astype(x.dtype)


def modnorm(x, g, shift, scale):
    return rmsnorm(x, g) * (1 + scale[:, None, :]) + shift[:, None, :]


def swiglu(h, w_in, w_out):
    gu = h @ w_in
    g, u = gu[..., :FFN_HIDDEN], gu[..., FFN_HIDDEN:]
    return (jax.nn.silu(g) * u) @ w_out


def s5_discretize(A_re, A_im, log_step, B_re, B_im):
    lr = -jnp.abs(A_re.astype(jnp.float32))
    li = A_im.astype(jnp.float32)
    dt = jnp.exp(log_step.astype(jnp.float32))[:, None]
    mag = jnp.exp(lr * dt)
    ar = mag * jnp.cos(li * dt)
    ai = mag * jnp.sin(li * dt)
    den = lr * lr + li * li
    cr = ((ar - 1) * lr + ai * li) / den
    ci = (ai * lr - (ar - 1) * li) / den
    Br = B_re.astype(jnp.float32)
    Bi = B_im.astype(jnp.float32)
    bbr = cr[..., None] * Br - ci[..., None] * Bi
    bbi = cr[..., None] * Bi + ci[..., None] * Br
    return ar, ai, bbr, bbi


def s5_combine(e1, e2):
    a1r, a1i, b1r, b1i = e1
    a2r, a2i, b2r, b2i = e2
    ar = a1r * a2r - a1i * a2i
    ai = a1r * a2i + a1i * a2r
    br = a2r * b1r - a2i * b1i + b2r
    bi = a2r * b1i + a2i * b1r + b2i
    return ar, ai, br, bi


def s5_direction(u, h0, ar, ai, bbr, bbi, C_re, C_im, reverse, want_y):
    Bn, L, D = u.shape
    ug = u.reshape(Bn, L, S5_G, S5_GC).swapaxes(0, 1)
    br = jnp.einsum('lbgc,gpc->lbgp', ug, bbr)
    bi = jnp.einsum('lbgc,gpc->lbgp', ug, bbi)
    if h0 is not None:
        idx = L - 1 if reverse else 0
        h0r, h0i = h0
        br = br.at[idx].add(ar * h0r - ai * h0i)
        bi = bi.at[idx].add(ar * h0i + ai * h0r)
    a_r = jnp.broadcast_to(ar, (L, 1, S5_G, S5_P))
    a_i = jnp.broadcast_to(ai, (L, 1, S5_G, S5_P))
    _, _, hr, hi = lax.associative_scan(s5_combine, (a_r, a_i, br, bi), reverse=reverse, axis=0)
    end = 0 if reverse else L - 1
    h_end = (hr[end], hi[end])
    y = None
    if want_y:
        y = (jnp.einsum('lbgp,gcp->blgc', hr, C_re.astype(jnp.float32))
             - jnp.einsum('lbgp,gcp->blgc', hi, C_im.astype(jnp.float32))).reshape(Bn, L, D)
    return y, h_end


def s5_mixer(hx, hc, w_in, A_re, A_im, log_step, B_re, B_im, C_re, C_im, D_skip, w_glu, w_out, ctx_out):
    dt = hx.dtype
    ux = (hx @ w_in).astype(jnp.float32)
    uc = (hc @ w_in).astype(jnp.float32)
    Dk = D_skip.astype(jnp.float32)
    yx = Dk * ux
    yc = Dk * uc if ctx_out else None
    for d in range(2):
        rev = d == 1
        ar, ai, bbr, bbi = s5_discretize(A_re[d], A_im[d], log_step[d], B_re[d], B_im[d])
        yc_d, hc_end = s5_direction(uc, None, ar, ai, bbr, bbi, C_re[d], C_im[d], rev, ctx_out)
        yx_d, _ = s5_direction(ux, hc_end, ar, ai, bbr, bbi, C_re[d], C_im[d], rev, True)
        yx = yx + yx_d
        if ctx_out:
            yc = yc + yc_d

    def glu_out(y):
        z = jax.nn.gelu(y).astype(dt) @ w_glu
        v, g = z[..., :D_MODEL], z[..., D_MODEL:]
        return (v * jax.nn.sigmoid(g)) @ w_out

    return glu_out(yx), (glu_out(yc) if ctx_out else None)


def axial_rope_tables(L):
    rows = L // GRID_W
    row = jnp.repeat(jnp.arange(rows, dtype=jnp.float32), GRID_W)
    col = jnp.tile(jnp.arange(GRID_W, dtype=jnp.float32), rows)
    axis_dim = MLA_ROPE // 2
    inv_freq = ROPE_BASE ** (-jnp.arange(0, axis_dim, 2, dtype=jnp.float32) / axis_dim)
    ang = jnp.stack([row[:, None] * inv_freq, col[:, None] * inv_freq], axis=1)
    return jnp.cos(ang), jnp.sin(ang)


def apply_axial_rope(t, cos, sin):
    nope, pe = t[..., :MLA_NOPE], t[..., MLA_NOPE:]
    pe = pe.reshape(*pe.shape[:-1], 2, 2, MLA_ROPE // 4)
    x1, x2 = pe[..., 0, :], pe[..., 1, :]
    c = cos[None, :, None].astype(t.dtype)
    s = sin[None, :, None].astype(t.dtype)
    rot = jnp.stack([x1 * c - x2 * s, x2 * c + x1 * s], axis=-2).reshape(*t.shape[:-1], MLA_ROPE)
    return jnp.concatenate([nope, rot], axis=-1)


def mla_kv(proj, g_kva, w_kv_b, g_k):
    Bn, L, _ = proj.shape
    c_kv = proj[..., MLA_QL:MLA_QL + MLA_KVL]
    k_pe = proj[..., MLA_QL + MLA_KVL:]
    kv = (rmsnorm(c_kv, g_kva) @ w_kv_b).reshape(Bn, L, MLA_H, MLA_NOPE + MLA_V)
    k_nope, v = kv[..., :MLA_NOPE], kv[..., MLA_NOPE:]
    k = jnp.concatenate([k_nope, jnp.broadcast_to(k_pe[:, :, None, :], (Bn, L, MLA_H, MLA_ROPE))], axis=-1)
    return rmsnorm(k, g_k), v


def mla_q(proj, g_qa, w_q_b, g_q):
    Bn, L, _ = proj.shape
    q = (rmsnorm(proj[..., :MLA_QL], g_qa) @ w_q_b).reshape(Bn, L, MLA_H, MLA_QK)
    return rmsnorm(q, g_q)


def softmax_attend(q, k, v):
    s = jnp.einsum('bqhd,bkhd->bhqk', q, k).astype(jnp.float32) * (MLA_QK ** -0.5)
    p = jax.nn.softmax(s, axis=-1)
    return jnp.einsum('bhqk,bkhd->bqhd', p.astype(v.dtype), v)


def mla_mixer(hx, hc, w_in, g_qa, g_kva, w_q_b, w_kv_b, g_q, g_k, w_o, ctx_out):
    Bn, L, _ = hx.shape
    px = hx @ w_in
    pc = hc @ w_in
    cos, sin = axial_rope_tables(L)
    qx = apply_axial_rope(mla_q(px, g_qa, w_q_b, g_q), cos, sin)
    kx, vx = mla_kv(px, g_kva, w_kv_b, g_k)
    kx = apply_axial_rope(kx, cos, sin)
    kc, vc = mla_kv(pc, g_kva, w_kv_b, g_k)
    k_all = jnp.concatenate([kc, kx], axis=1)
    v_all = jnp.concatenate([vc, vx], axis=1)
    nblk = L // Q_BLOCK
    qb = qx.reshape(Bn, nblk, Q_BLOCK, MLA_H, MLA_QK).swapaxes(0, 1)
    ob = lax.map(lambda qq: softmax_attend(qq, k_all, v_all), qb)
    ox = ob.swapaxes(0, 1).reshape(Bn, L, MLA_H * MLA_V) @ w_o
    oc = None
    if ctx_out:
        qc = mla_q(pc, g_qa, w_q_b, g_q)
        oc = softmax_attend(qc, kc, vc).reshape(hc.shape[0], hc.shape[1], MLA_H * MLA_V) @ w_o
    return ox, oc


def setup_inputs(seed: int = 0) -> dict:
    key = jax.random.key(seed)
    ks = iter(jax.random.split(key, 64))
    f32 = jnp.float32
    D = D_MODEL
    NA = (DEPTH + 1) // 2
    NB = DEPTH // 2

    def nrm(shape, scale):
        return jax.random.normal(next(ks), shape, f32) * scale

    n = jnp.arange(S5_P, dtype=f32)
    return {
        'x': nrm((BATCH, SEQ, D), 1.0),
        'c': nrm((BATCH, D), 1.0),
        'ctx': nrm((BATCH, CTX_LEN, D), 1.0),
        'c_ctx': nrm((D,), 1.0),
        'mod_w': nrm((DEPTH, D, 6 * D), 0.5 * D ** -0.5),
        'mod_b': nrm((DEPTH, 6 * D), 0.02),
        'norm_mix': 1.0 + nrm((DEPTH, D), 0.02),
        'norm_ffn': 1.0 + nrm((DEPTH, D), 0.02),
        'ffn_w_in': nrm((DEPTH, D, 2 * FFN_HIDDEN), D ** -0.5),
        'ffn_w_out': nrm((DEPTH, FFN_HIDDEN, D), FFN_HIDDEN ** -0.5),
        's5_w_in': nrm((NA, D, D), D ** -0.5),
        's5_A_re': -0.5 + nrm((NA, 2, S5_G, S5_P), 0.01),
        's5_A_im': math.pi * n + nrm((NA, 2, S5_G, S5_P), 0.01),
        's5_log_step': jax.random.uniform(next(ks), (NA, 2, S5_G), f32, math.log(1e-3), math.log(1e-1)),
        's5_B_re': nrm((NA, 2, S5_G, S5_P, S5_GC), (2 * S5_GC) ** -0.5),
        's5_B_im': nrm((NA, 2, S5_G, S5_P, S5_GC), (2 * S5_GC) ** -0.5),
        's5_C_re': nrm((NA, 2, S5_G, S5_GC, S5_P), S5_P ** -0.5),
        's5_C_im': nrm((NA, 2, S5_G, S5_GC, S5_P), S5_P ** -0.5),
        's5_D': nrm((NA, D), 1.0),
        's5_w_glu': nrm((NA, D, 2 * D), D ** -0.5),
        's5_w_out': nrm((NA, D, D), D ** -0.5),
        'mla_w_in': nrm((NB, D, MLA_QL + MLA_KVL + MLA_ROPE), D ** -0.5),
        'mla_q_a_norm': 1.0 + nrm((NB, MLA_QL), 0.02),
        'mla_kv_a_norm': 1.0 + nrm((NB, MLA_KVL), 0.02),
        'mla_w_q_b': nrm((NB, MLA_QL, MLA_H * MLA_QK), MLA_QL ** -0.5),
        'mla_w_kv_b': nrm((NB, MLA_KVL, MLA_H * (MLA_NOPE + MLA_V)), MLA_KVL ** -0.5),
        'mla_q_norm': 1.0 + nrm((NB, MLA_QK), 0.02),
        'mla_k_norm': 1.0 + nrm((NB, MLA_QK), 0.02),
        'mla_w_o': nrm((NB, MLA_H * MLA_V, D), (MLA_H * MLA_V) ** -0.5),
    }


def reference(x, c, ctx, c_ctx, mod_w, mod_b, norm_mix, norm_ffn, ffn_w_in, ffn_w_out,
              s5_w_in, s5_A_re, s5_A_im, s5_log_step, s5_B_re, s5_B_im, s5_C_re, s5_C_im, s5_D,
              s5_w_glu, s5_w_out,
              mla_w_in, mla_q_a_norm, mla_kv_a_norm, mla_w_q_b, mla_w_kv_b, mla_q_norm, mla_k_norm, mla_w_o):
    D = D_MODEL
    for i in range(DEPTH):
        last = i == DEPTH - 1
        j = i // N_MIXERS
        mod = jax.nn.silu(c) @ mod_w[i] + mod_b[i]
        mod_c = jax.nn.silu(c_ctx)[None, :] @ mod_w[i] + mod_b[i]
        sh_m, sc_m, gt_m, sh_f, sc_f, gt_f = [mod[:, k * D:(k + 1) * D] for k in range(6)]
        csh_m, csc_m, cgt_m, csh_f, csc_f, cgt_f = [mod_c[:, k * D:(k + 1) * D] for k in range(6)]
        hx = modnorm(x, norm_mix[i], sh_m, sc_m)
        hc = modnorm(ctx, norm_mix[i], csh_m, csc_m)
        if i % N_MIXERS == 0:
            ox, oc = s5_mixer(hx, hc, s5_w_in[j], s5_A_re[j], s5_A_im[j], s5_log_step[j],
                              s5_B_re[j], s5_B_im[j], s5_C_re[j], s5_C_im[j], s5_D[j],
                              s5_w_glu[j], s5_w_out[j], not last)
        else:
            ox, oc = mla_mixer(hx, hc, mla_w_in[j], mla_q_a_norm[j], mla_kv_a_norm[j], mla_w_q_b[j],
                               mla_w_kv_b[j], mla_q_norm[j], mla_k_norm[j], mla_w_o[j], not last)
        x = x + gt_m[:, None, :] * ox.astype(x.dtype)
        x = x + gt_f[:, None, :] * swiglu(modnorm(x, norm_ffn[i], sh_f, sc_f), ffn_w_in[i], ffn_w_out[i])
        if not last:
            ctx = ctx + cgt_m[:, None, :] * oc.astype(ctx.dtype)
            ctx = ctx + cgt_f[:, None, :] * swiglu(modnorm(ctx, norm_ffn[i], csh_f, csc_f), ffn_w_in[i], ffn_w_out[i])
    return x
```

```cpp
#include <hip/hip_runtime.h>
#include <hip/hip_cooperative_groups.h>
#include <cstdio>
#include <cstdint>
namespace cg = cooperative_groups;

#ifndef MK_MULTI
#define MK_MULTI 0
#endif

constexpr int DM = 1024, NBATCH = 8, SEQ = 4096, CTXL = 256;
constexpr int NLAT = NBATCH * SEQ, NCTX = NBATCH * CTXL, NTOK = NLAT + NCTX;
constexpr int FH = 2816;
constexpr int SPB = CTXL + SEQ;
constexpr int NCH = SPB / 16;
constexpr int GROWS = NBATCH * NCH;
constexpr int GPAD = 2304;
constexpr int NHEAD = 16, QKD = 96, VD = 64, QLR = 512, KVLR = 256;
constexpr float EPS = 1e-6f;
constexpr int MODS = 6 * DM;

constexpr size_t MiB = 1u << 20;
constexpr size_t WS_CTL = 0, CTL_ZERO_BYTES = 1 * MiB;
constexpr size_t WS_MOD = 4096;
constexpr size_t WS_BAR = 512 * 1024;
constexpr size_t WS_APOW = 1 * MiB;
constexpr size_t WS_BBAR = 3 * MiB;
constexpr size_t WS_KC = 4 * MiB;
constexpr size_t WS_KPE = 6 * MiB;
constexpr size_t WS_WBT = 9 * MiB;
constexpr size_t WS_TBT = 17 * MiB;
constexpr size_t WS_W_S5IN = 33 * MiB, WS_W_GLU = 35 * MiB, WS_W_S5OUT = 39 * MiB, WS_W_FFIN0 = 41 * MiB, WS_W_FFIN1 = 52 * MiB;
constexpr size_t WS_W_FFOUT0 = 63 * MiB, WS_W_FFOUT1 = 69 * MiB, WS_W_MLAIN = 75 * MiB, WS_W_QB = 77 * MiB, WS_W_KVB = 79 * MiB, WS_W_O = 80 * MiB;
constexpr size_t WS_X = 96 * MiB;
constexpr size_t WS_H = 232 * MiB;
constexpr size_t WS_BIG = 300 * MiB;
constexpr size_t WS_ACAT = WS_BIG;
constexpr size_t WS_G = WS_BIG, WS_A1 = WS_BIG, WS_PX = WS_BIG, WS_CKV = 9 * MiB  , WS_KH = WS_BIG, WS_VH = 444 * MiB, WS_A2 = WS_BIG;
constexpr size_t WS_PPART = 488 * MiB;
constexpr size_t OUT_QL = 96 * MiB;
constexpr size_t WS_END = 512 * MiB;

constexpr int LDS_BYTES = 147456;
constexpr int NWAVES = 8;

#define LAS __attribute__((address_space(3)))
typedef unsigned short bf16;
typedef float f32x2 __attribute__((ext_vector_type(2)));
typedef unsigned u32x2 __attribute__((ext_vector_type(2)));
#define LDS_WAIT() asm volatile("s_waitcnt lgkmcnt(0)" ::: "memory")

namespace pg8 {
#define PG8_LAS __attribute__((address_space(3)))
typedef unsigned short bf16_t;
typedef short bf16x8 __attribute__((ext_vector_type(8)));
typedef float f32x4 __attribute__((ext_vector_type(4)));
typedef unsigned u32x4 __attribute__((ext_vector_type(4)));
constexpr int BM = 256, BK = 64, HALF = 128, HTB = HALF * BK * 2  , STAGE_BYTES = 8 * HTB, NXCD = 8, WGM = 8;

__host__ __device__ __forceinline__ int lds_byte(int r, int c) { const int st = (r >> 4) * 2 + (c >> 5), rr = r & 15, cc = c & 31, ob = rr * 64 + cc * 2; return st * 1024 + (ob ^ (((ob >> 9) & 1) << 5)); }
__host__ __device__ __forceinline__ void stage_rc(int b, int& R, int& C) { const int st = b / 1024, sb = b % 1024, swz = sb ^ (((sb >> 9) & 1) << 5); R = (st >> 1) * 16 + swz / 64; C = (st & 1) * 32 + (swz % 64) / 2; }
__host__ __device__ __forceinline__ int perm32(int rho) { const int n = rho >> 4, i = rho & 15; return 8 * (i >> 2) + 4 * n + (i & 3); }

struct Unit { int pm, pn; };
struct Gemm { const bf16_t* A; const bf16_t* Bt; int M, N, K, lda; int ldb = 0; };

struct StaticOrder {
    int nM, nN, nwg, G, c;
    __host__ __device__ void init(int M, int N, int G_, int c_) { nM = M / BM; nN = N / BM; nwg = nM * nN; G = G_; c = c_; }
    __host__ __device__ bool next(int i, Unit& u) const {
        const long L = (long)i * G + c; if (L >= nwg) return false;
        int wgid = (int)L; { const int q = nwg / NXCD, r = nwg % NXCD, xcd = wgid % NXCD, off = wgid / NXCD; wgid = (xcd < r ? xcd * (q + 1) : r * (q + 1) + (xcd - r) * q) + off; }
        const int nig = WGM * nN, gid = wgid / nig, fm = gid * WGM, gsz = (nM - fm) < WGM ? (nM - fm) : WGM;
        u.pm = fm + ((wgid % nig) % gsz); u.pn = (wgid % nig) / gsz; return true;
    }
    __device__ __forceinline__ void a_ready(const Unit&) const {}
    __device__ __forceinline__ void done(const Unit&) const {}
};

__device__ __forceinline__ unsigned cvt_pk_bf16(float lo, float hi) { unsigned r; asm volatile("v_cvt_pk_bf16_f32 %0, %1, %2" : "=v"(r) : "v"(lo), "v"(hi)); return r; }

__device__ __forceinline__ u32x4 pack8(f32x4 v0, f32x4 v1) { u32x4 w; w.x = cvt_pk_bf16(v0[0], v0[1]); w.y = cvt_pk_bf16(v0[2], v0[3]); w.z = cvt_pk_bf16(v1[0], v1[1]); w.w = cvt_pk_bf16(v1[2], v1[3]); return w; }
__device__ __forceinline__ float sigmoidf_(float x) { return __builtin_amdgcn_rcpf(1.0f + __expf(-x)); }

struct EpiPlain {
    static constexpr bool PERM = true, AFTER_DRAIN = false;
    bf16_t* O; int ldc;
    __device__ __forceinline__ void operator()(const f32x4 (&acc)[2][2][4][2], const Unit& u, int wr, int wc, int fr, int fq) const {
        const int row0 = u.pm * BM + wr * 64 + fr, col0 = u.pn * BM + wc * 32 + 8 * fq;
#pragma unroll
        for (int ai = 0; ai < 2; ++ai)
#pragma unroll
            for (int m = 0; m < 4; ++m) { bf16_t* rowp = O + (size_t)(row0 + ai * HALF + m * 16) * ldc + col0;
#pragma unroll
                for (int bj = 0; bj < 2; ++bj) *(u32x4*)(rowp + bj * HALF) = pack8(acc[ai][bj][m][0], acc[ai][bj][m][1]); }
    }
};
template <int ACT> struct EpiGate {
    static constexpr bool PERM = true, AFTER_DRAIN = false;
    bf16_t* O; int ldc;
    __device__ __forceinline__ void operator()(const f32x4 (&acc)[2][2][4][2], const Unit& u, int wr, int wc, int fr, int fq) const {
        const int row0 = u.pm * BM + wr * 64 + fr, col0 = u.pn * HALF + wc * 32 + 8 * fq;
#pragma unroll
        for (int ai = 0; ai < 2; ++ai)
#pragma unroll
            for (int m = 0; m < 4; ++m) {
                f32x4 o[2];
#pragma unroll
                for (int n = 0; n < 2; ++n)
#pragma unroll
                    for (int i = 0; i < 4; ++i) { const float a = acc[ai][0][m][n][i], b = acc[ai][1][m][n][i];
                        o[n][i] = (ACT == 0) ? a * sigmoidf_(b) : a * sigmoidf_(a) * b; }
                *(u32x4*)(O + (size_t)(row0 + ai * HALF + m * 16) * ldc + col0) = pack8(o[0], o[1]); }
    }
};
template <bool BB, bool OB> struct EpiRes {
    static constexpr bool PERM = false, AFTER_DRAIN = false;
    const void* base_lat; const void* base_ctx; void* out_lat; void* out_ctx; const float* gate;
    int row_off = 0;
    __device__ __forceinline__ void operator()(const f32x4 (&acc)[2][2][4][2], const Unit& u, int wr, int wc, int fr, int fq) const {
        int row0 = u.pm * BM + wr * 64 + fr + row_off; const bool isctx = row0 >= NLAT; const int b = isctx ? 8 : (row0 >> 12);
        const void* bp = isctx ? base_ctx : base_lat; void* op = isctx ? out_ctx : out_lat; if (isctx) row0 -= NLAT;
        const int col0 = u.pn * BM + wc * 32 + 4 * fq;
        f32x4 gv[2][2];
#pragma unroll
        for (int bj = 0; bj < 2; ++bj)
#pragma unroll
            for (int n = 0; n < 2; ++n) gv[bj][n] = *(const f32x4*)(gate + b * MODS + col0 + bj * HALF + n * 16);
#pragma unroll
        for (int ai = 0; ai < 2; ++ai)
#pragma unroll
            for (int m = 0; m < 4; ++m) { const size_t off = (size_t)(row0 + ai * HALF + m * 16) * DM + col0;
#pragma unroll
                for (int bj = 0; bj < 2; ++bj)
#pragma unroll
                    for (int n = 0; n < 2; ++n) { const size_t o2 = off + bj * HALF + n * 16; f32x4 bs;
                        if (BB) { const u32x2 r = *(const u32x2*)((const bf16_t*)bp + o2); bs = (f32x4){__uint_as_float(r.x << 16), __uint_as_float(r.x & 0xffff0000u), __uint_as_float(r.y << 16), __uint_as_float(r.y & 0xffff0000u)}; }
                        else bs = *(const f32x4*)((const float*)bp + o2);
                        const f32x4 o = bs + gv[bj][n] * acc[ai][bj][m][n];
                        if (OB) { u32x2 w; w.x = cvt_pk_bf16(o[0], o[1]); w.y = cvt_pk_bf16(o[2], o[3]); *(u32x2*)((bf16_t*)op + o2) = w; }
                        else *(f32x4*)((float*)op + o2) = o; } }
    }
};
struct EpiPart {
    static constexpr bool PERM = false, AFTER_DRAIN = false;
    float* P;
    __device__ __forceinline__ void operator()(const f32x4 (&acc)[2][2][4][2], const Unit& u, int wr, int wc, int fr, int fq) const {
        float* base = P + (size_t)(u.pm * BM + wr * 64 + fr) * DM + u.pn * BM + wc * 32 + 4 * fq;
#pragma unroll
        for (int ai = 0; ai < 2; ++ai)
#pragma unroll
            for (int m = 0; m < 4; ++m)
#pragma unroll
                for (int bj = 0; bj < 2; ++bj)
#pragma unroll
                    for (int n = 0; n < 2; ++n) *(f32x4*)(base + (size_t)(ai * HALF + m * 16) * DM + bj * HALF + n * 16) = acc[ai][bj][m][n];
    }
};
__device__ __forceinline__ void row_to_bsp(int row, int& b, int& sp) { if (row < NLAT) { b = row >> 12; sp = CTXL + (row & (SEQ - 1)); } else { const int rr = row - NLAT; b = rr >> 8; sp = rr & (CTXL - 1); } }
__device__ __forceinline__ int bsp_to_row(int b, int sp) { return sp < CTXL ? NLAT + b * CTXL + sp : b * SEQ + sp - CTXL; }
struct EpiU {
    static constexpr bool PERM = true, AFTER_DRAIN = false;
    bf16_t* ACAT; int pm_off = 0;
    __device__ __forceinline__ void operator()(const f32x4 (&acc)[2][2][4][2], const Unit& u, int wr, int wc, int fr, int fq) const {
        const int pmm = u.pm + pm_off;
        const int b = pmm < 128 ? (pmm >> 4) : (pmm - 128), sp0 = (pmm < 128 ? CTXL + (pmm & 15) * 256 : 0) + wr * 64 + fr;
        const int col0 = u.pn * BM + wc * 32 + 8 * fq, g0 = col0 >> 4, c0 = col0 & 15;
        bf16_t* base = ACAT + ((size_t)(g0 * GPAD + b * NCH) * 512 + c0);
#pragma unroll
        for (int ai = 0; ai < 2; ++ai)
#pragma unroll
            for (int m = 0; m < 4; ++m) { const int sp = sp0 + ai * HALF + m * 16; bf16_t* rp = base + (size_t)(sp >> 4) * 512 + (sp & 15) * 16;
#pragma unroll
                for (int bj = 0; bj < 2; ++bj) *(u32x4*)(rp + (size_t)bj * 8 * GPAD * 512) = pack8(acc[ai][bj][m][0], acc[ai][bj][m][1]); }
    }
};
struct EpiE {
    static constexpr bool PERM = false, AFTER_DRAIN = false;
    float* E;
    __device__ __forceinline__ void operator()(const f32x4 (&acc)[2][2][4][2], const Unit& u, int wr, int wc, int fr, int fq) const {
        const int g = u.pn, it = u.pm - 9 * g, rl0 = it * BM + wr * 64 + fr, col0 = wc * 32 + 4 * fq;
        float* base = E + ((size_t)g * GROWS + rl0) * 256 + col0;
#pragma unroll
        for (int ai = 0; ai < 2; ++ai) { if (ai == 1 && it == 8) continue;
#pragma unroll
            for (int m = 0; m < 4; ++m) { float* rp = base + (size_t)(ai * HALF + m * 16) * 256;
#pragma unroll
                for (int bj = 0; bj < 2; ++bj)
#pragma unroll
                    for (int n = 0; n < 2; ++n) *(f32x4*)(rp + bj * HALF + n * 16) = acc[ai][bj][m][n]; } }
    }
};
struct EpiY {
    static constexpr bool PERM = true, AFTER_DRAIN = false;
    bf16_t* Y;
    __device__ __forceinline__ void operator()(const f32x4 (&acc)[2][2][4][2], const Unit& u, int wr, int wc, int fr, int fq) const {
        const int g = u.pn, it = u.pm - 9 * g, rl0 = it * BM + wr * 64 + fr, col0 = wc * 32 + 8 * fq, tau0 = col0 >> 4, c0 = col0 & 15;
#pragma unroll
        for (int ai = 0; ai < 2; ++ai) { if (ai == 1 && it == 8) continue;
#pragma unroll
            for (int m = 0; m < 4; ++m) { const int rl = rl0 + ai * HALF + m * 16; const int b = rl / NCH, ch = rl - b * NCH;
#pragma unroll
                for (int bj = 0; bj < 2; ++bj) { const int row = bsp_to_row(b, ch * 16 + tau0 + bj * 8);
                    f32x4 o[2];
#pragma unroll
                    for (int n = 0; n < 2; ++n)
#pragma unroll
                        for (int i = 0; i < 4; ++i) { const float y = acc[ai][bj][m][n][i]; const float z = 0.7978845608028654f * (y + 0.044715f * y * y * y); o[n][i] = y * sigmoidf_(2.0f * z); }
                    *(u32x4*)(Y + (size_t)row * DM + g * 16 + c0) = pack8(o[0], o[1]); } } }
    }
};
struct EpiKV {
    static constexpr bool PERM = true, AFTER_DRAIN = false;
    bf16_t* KH; bf16_t* VH; const bf16_t* KPE; const float* gk;
    __device__ __forceinline__ void operator()(const f32x4 (&acc)[2][2][4][2], const Unit& u, int wr, int wc, int fr, int fq) const {
        const bool lat = u.pm < 128;
        const int b = lat ? (u.pm >> 4) : (u.pm - 128), sp0 = (lat ? CTXL + (u.pm & 15) * 256 : 0) + wr * 64 + fr;
        const int row0 = u.pm * BM + wr * 64 + fr;
        if (u.pn < 4) {
            const int h = 4 * u.pn + wc;
            f32x4 g0[2], g1[2];
#pragma unroll
            for (int bj = 0; bj < 2; ++bj) { g0[bj] = *(const f32x4*)(gk + 32 * bj + 8 * fq); g1[bj] = *(const f32x4*)(gk + 32 * bj + 8 * fq + 4); }
            const f32x4 gp0 = *(const f32x4*)(gk + 64 + 8 * fq), gp1 = *(const f32x4*)(gk + 64 + 8 * fq + 4);
            const float invf[8] = {1.0f, 0.31622776601683794f, 0.1f, 0.031622776601683794f, 0.01f, 0.0031622776601683794f, 0.001f, 0.00031622776601683794f};
            const float sgn = (fq & 1) ? 1.0f : -1.0f;
#pragma unroll
            for (int ai = 0; ai < 2; ++ai)
#pragma unroll
                for (int m = 0; m < 4; ++m) { const int row = row0 + ai * HALF + m * 16, sp = sp0 + ai * HALF + m * 16;
                    const u32x4 praw = *(const u32x4*)(KPE + (size_t)row * 32 + 8 * fq); float pe[8];
#pragma unroll
                    for (int e = 0; e < 4; ++e) { pe[2 * e] = __uint_as_float(praw[e] << 16); pe[2 * e + 1] = __uint_as_float(praw[e] & 0xffff0000u); }
                    float ss = 0.f;
#pragma unroll
                    for (int bj = 0; bj < 2; ++bj)
#pragma unroll
                        for (int n = 0; n < 2; ++n) { const f32x4 v = acc[ai][bj][m][n]; ss += (v[0] * v[0] + v[1] * v[1]) + (v[2] * v[2] + v[3] * v[3]); }
#pragma unroll
                    for (int e = 0; e < 8; ++e) ss += pe[e] * pe[e];
                    ss += __shfl_xor(ss, 16); ss += __shfl_xor(ss, 32);
                    const float rstd = rsqrtf(ss * (1.0f / 96.0f) + EPS);
                    bf16_t* kd = KH + ((size_t)(b * NHEAD + h) * SPB + sp) * 128;
#pragma unroll
                    for (int bj = 0; bj < 2; ++bj) *(u32x4*)(kd + 32 * bj + 8 * fq) = pack8(acc[ai][bj][m][0] * rstd * g0[bj], acc[ai][bj][m][1] * rstd * g1[bj]);
                    const int l = sp - CTXL; const float pos = (fq >> 1) ? (float)(l & 63) : (float)(l >> 6);
                    f32x4 o0, o1;
#pragma unroll
                    for (int e = 0; e < 8; ++e) { const float own = pe[e] * rstd * (e < 4 ? gp0[e & 3] : gp1[e & 3]); const float other = __shfl_xor(own, 16);
                        float cs = 1.f, sn = 0.f; if (lat) { const float ang = pos * invf[e]; cs = __cosf(ang); sn = __sinf(ang); }
                        const float r = own * cs + sgn * other * sn; if (e < 4) o0[e & 3] = r; else o1[e & 3] = r; }
                    *(u32x4*)(kd + 64 + 8 * fq) = pack8(o0, o1);
                    if (fq < 2) *(u32x4*)(kd + 96 + 8 * fq) = (u32x4){fq == 0 ? 0x3F80u : 0u, 0u, 0u, 0u};
                }
        } else {
            const int hl = wc >> 1, vd0 = (32 * wc + 8 * fq) & 63;
            bf16_t* base = VH + ((size_t)(b * NHEAD + 4 * (u.pn - 4) + hl) * SPB + sp0) * VD + vd0;
#pragma unroll
            for (int ai = 0; ai < 2; ++ai)
#pragma unroll
                for (int m = 0; m < 4; ++m)
#pragma unroll
                    for (int bj = 0; bj < 2; ++bj) *(u32x4*)(base + (size_t)(ai * HALF + m * 16) * VD + (size_t)(2 * bj) * SPB * VD) = pack8(acc[ai][bj][m][0], acc[ai][bj][m][1]);
        }
    }
};
struct GroupOrder {
    int G, c;
    __device__ __forceinline__ bool next(int i, Unit& u) const { const long L = (long)i * G + c; if (L >= 64 * 9) return false; u.pm = (int)L; u.pn = (int)L / 9; return true; }
    __device__ __forceinline__ void a_ready(const Unit&) const {}
    __device__ __forceinline__ void done(const Unit&) const {}
};

template <class Epi, class Sched, bool ALIGN_EPI = false, bool SP2 = false>
__device__ __forceinline__ void gemm_phase(PG8_LAS unsigned char* lds, const Gemm g, const Sched& S, const Epi& E) {
    const int tid = threadIdx.x, wid = __builtin_amdgcn_readfirstlane(tid >> 6), lane = tid & 63, wr = wid >> 2, wc = wid & 3, fr = lane & 15, fq = lane >> 4;
    int K_ = g.K; asm volatile("" : "+s"(K_));
    const int K = K_, nt = K / BK, ldb = g.ldb ? g.ldb : K_;
    unsigned voffA[2], voffB[2];
#pragma unroll
    for (int i = 0; i < 2; ++i) { int R, C; stage_rc(tid * 16 + i * 8192, R, C); const int Rb = Epi::PERM ? ((R & ~31) + perm32(R & 31)) : R;
        voffA[i] = (unsigned)(R * g.lda + C) * 2u; voffB[i] = (unsigned)(Rb * ldb + C) * 2u; }
    const size_t kstep = (size_t)(BK * 2);
    const size_t hstep = (size_t)HALF * ldb * 2;
    const size_t tstep = 2 * hstep; const size_t hstepA = (size_t)HALF * g.lda * 2, tstepA = 2 * hstepA;
    const unsigned ldsw = (unsigned)wid * 1024u;
    const int aoff = lds_byte(wr * 64 + fr, fq * 8), boff = lds_byte(wc * 32 + fr, fq * 8);
#define PG8_SA(b, h) (((b) * 2 + (h)) * HTB)
#define PG8_SB(b, h) ((4 + (b) * 2 + (h)) * HTB)
#define PG8_STAGE(bufoff, gbase, voff) do { _Pragma("unroll") for (int _i = 0; _i < 2; ++_i) \
        __builtin_amdgcn_global_load_lds((const unsigned*)((const char*)(gbase) + (voff)[_i]), (PG8_LAS unsigned*)(lds + (bufoff) + ldsw + _i * 8192), 16, 0, 0); } while (0)
#define PG8_LDA(dst, b, h) do { _Pragma("unroll") for (int m = 0; m < 4; ++m) _Pragma("unroll") for (int k = 0; k < 2; ++k) dst[m][k] = *(const PG8_LAS bf16x8*)(lds + PG8_SA(b, h) + aoff + m * 2048 + k * 1024); } while (0)
#define PG8_LDB(dst, b, h) do { _Pragma("unroll") for (int n = 0; n < 2; ++n) _Pragma("unroll") for (int k = 0; k < 2; ++k) dst[n][k] = *(const PG8_LAS bf16x8*)(lds + PG8_SB(b, h) + boff + n * 2048 + k * 1024); } while (0)
#define PG8_MMA(ai, bj, At, Bt) do { __builtin_amdgcn_s_setprio(1); _Pragma("unroll") for (int m = 0; m < 4; ++m) _Pragma("unroll") for (int n = 0; n < 2; ++n) _Pragma("unroll") for (int k = 0; k < 2; ++k) \
        acc[ai][bj][m][n] = __builtin_amdgcn_mfma_f32_16x16x32_bf16(Bt[n][k], At[m][k], acc[ai][bj][m][n], 0, 0, 0); __builtin_amdgcn_s_setprio(0); } while (0)
#define PG8_WAIT_V(n) asm volatile("s_waitcnt vmcnt(" #n ")" ::: "memory")
#define PG8_WAIT_L(n) asm volatile("s_waitcnt lgkmcnt(" #n ")" ::: "memory")
#define PG8_BAR __builtin_amdgcn_s_barrier()
#define PG8_SCHED __builtin_amdgcn_sched_barrier(0)
    Unit cur, nxt; int ui = 0;
    if (!S.next(0, cur)) return;
    f32x4 acc[2][2][4][2];
#pragma unroll
    for (int a = 0; a < 2; ++a)
#pragma unroll
        for (int b = 0; b < 2; ++b)
#pragma unroll
            for (int m = 0; m < 4; ++m)
#pragma unroll
                for (int n = 0; n < 2; ++n) acc[a][b][m][n] = (f32x4){0.f, 0.f, 0.f, 0.f};
    bf16x8 At[4][2], B0[2][2], B1[2][2];
    const char* cA = (const char*)g.A + (size_t)cur.pm * tstepA; const char* cB = (const char*)g.Bt + (size_t)cur.pn * tstep;
    S.a_ready(cur);
    if constexpr (SP2) {
        PG8_STAGE(PG8_SB(0, 0), cB, voffB); PG8_STAGE(PG8_SB(0, 1), cB + hstep, voffB); PG8_STAGE(PG8_SA(0, 0), cA, voffA); PG8_STAGE(PG8_SA(0, 1), cA + hstepA, voffA);
        if (wr == 1) PG8_BAR;
        PG8_WAIT_V(2); PG8_BAR;
        PG8_STAGE(PG8_SB(1, 0), cB + kstep, voffB); PG8_STAGE(PG8_SA(1, 0), cA + kstep, voffA); PG8_STAGE(PG8_SB(1, 1), cB + hstep + kstep, voffB);
        PG8_WAIT_V(6); PG8_BAR;
    } else {
        PG8_STAGE(PG8_SB(0, 0), cB, voffB); PG8_STAGE(PG8_SA(0, 0), cA, voffA); PG8_STAGE(PG8_SB(0, 1), cB + hstep, voffB); PG8_STAGE(PG8_SA(0, 1), cA + hstepA, voffA);
        if (wr == 1) PG8_BAR;
        PG8_WAIT_V(4); PG8_BAR;
        PG8_STAGE(PG8_SB(1, 0), cB + kstep, voffB); PG8_STAGE(PG8_SA(1, 0), cA + kstep, voffA); PG8_STAGE(PG8_SB(1, 1), cB + hstep + kstep, voffB);
        PG8_WAIT_V(6); PG8_BAR;
    }
    for (;;) {
        const bool has_next = S.next(ui + 1, nxt);
        const char* nA = has_next ? (const char*)g.A + (size_t)nxt.pm * tstepA : cA; const char* nB = has_next ? (const char*)g.Bt + (size_t)nxt.pn * tstep : cB;
        for (int t = 0; t < nt; t += 2) {
            const bool last = (t == nt - 2);
            const char* a1 = cA + (size_t)(t + 1) * kstep;
            const char* a2 = last ? nA : cA + (size_t)(t + 2) * kstep; const char* b2 = last ? nB : cB + (size_t)(t + 2) * kstep;
            const char* a3 = a2 + kstep; const char* b3 = b2 + kstep;
            if (last && has_next) S.a_ready(nxt);
            if constexpr (SP2) {
            PG8_LDB(B0, 0, 0); PG8_LDB(B1, 0, 1); PG8_SCHED; PG8_LDA(At, 0, 0); PG8_STAGE(PG8_SA(1, 1), a1 + hstepA, voffA);
            PG8_WAIT_V(8); PG8_WAIT_L(0); PG8_BAR; PG8_MMA(0, 0, At, B0); PG8_MMA(0, 1, At, B1); PG8_BAR; PG8_SCHED;
            PG8_LDA(At, 0, 1); PG8_STAGE(PG8_SB(0, 0), b2, voffB); PG8_STAGE(PG8_SB(0, 1), b2 + hstep, voffB); PG8_STAGE(PG8_SA(0, 0), a2, voffA);
            PG8_WAIT_V(8); PG8_WAIT_L(0); PG8_BAR; PG8_MMA(1, 0, At, B0); PG8_MMA(1, 1, At, B1); PG8_BAR; PG8_SCHED;
            PG8_LDB(B0, 1, 0); PG8_LDB(B1, 1, 1); PG8_SCHED; PG8_LDA(At, 1, 0); PG8_STAGE(PG8_SA(0, 1), a2 + hstepA, voffA);
            PG8_WAIT_V(8); PG8_WAIT_L(0); PG8_BAR; PG8_MMA(0, 0, At, B0); PG8_MMA(0, 1, At, B1); PG8_BAR; PG8_SCHED;
            PG8_LDA(At, 1, 1); PG8_STAGE(PG8_SB(1, 0), b3, voffB); PG8_STAGE(PG8_SB(1, 1), b3 + hstep, voffB); PG8_STAGE(PG8_SA(1, 0), a3, voffA);
            PG8_WAIT_V(8); PG8_WAIT_L(0); PG8_BAR; PG8_MMA(1, 0, At, B0); PG8_MMA(1, 1, At, B1); PG8_BAR; PG8_SCHED;
            } else {
            PG8_LDB(B0, 0, 0); PG8_SCHED; PG8_LDA(At, 0, 0); PG8_STAGE(PG8_SA(1, 1), a1 + hstepA, voffA);
            PG8_WAIT_L(8); PG8_BAR; PG8_WAIT_L(0); PG8_MMA(0, 0, At, B0); PG8_BAR; PG8_SCHED;
            PG8_LDB(B1, 0, 1); PG8_STAGE(PG8_SB(0, 0), b2, voffB);
            PG8_BAR; PG8_WAIT_L(0); PG8_MMA(0, 1, At, B1); PG8_BAR;
            PG8_LDA(At, 0, 1); PG8_STAGE(PG8_SA(0, 0), a2, voffA);
            PG8_BAR; PG8_WAIT_L(0); PG8_MMA(1, 0, At, B0); PG8_BAR; PG8_SCHED;
            PG8_STAGE(PG8_SB(0, 1), b2 + hstep, voffB);
            PG8_WAIT_V(6); PG8_BAR; PG8_MMA(1, 1, At, B1); PG8_BAR;
            PG8_LDB(B0, 1, 0); PG8_SCHED; PG8_LDA(At, 1, 0); PG8_STAGE(PG8_SA(0, 1), a2 + hstepA, voffA);
            PG8_WAIT_L(8); PG8_BAR; PG8_WAIT_L(0); PG8_MMA(0, 0, At, B0); PG8_BAR; PG8_SCHED;
            PG8_LDB(B1, 1, 1); PG8_STAGE(PG8_SB(1, 0), b3, voffB);
            PG8_BAR; PG8_WAIT_L(0); PG8_MMA(0, 1, At, B1); PG8_BAR;
            PG8_LDA(At, 1, 1); PG8_STAGE(PG8_SA(1, 0), a3, voffA);
            PG8_BAR; PG8_WAIT_L(0); PG8_MMA(1, 0, At, B0); PG8_BAR; PG8_SCHED;
            PG8_STAGE(PG8_SB(1, 1), b3 + hstep, voffB);
            PG8_WAIT_V(6); PG8_BAR; PG8_MMA(1, 1, At, B1); PG8_BAR;
            }
        }
        if constexpr (ALIGN_EPI) { if (wr == 0) PG8_BAR; }
        if constexpr (!Epi::AFTER_DRAIN) { E(acc, cur, wr, wc, fr, fq); S.done(cur); }
        if (!has_next) break;
#pragma unroll
        for (int a = 0; a < 2; ++a)
#pragma unroll
            for (int b = 0; b < 2; ++b)
#pragma unroll
                for (int m = 0; m < 4; ++m)
#pragma unroll
                    for (int n = 0; n < 2; ++n) acc[a][b][m][n] = (f32x4){0.f, 0.f, 0.f, 0.f};
        cur = nxt; cA = nA; cB = nB; ++ui;
        if constexpr (ALIGN_EPI) { if (wr == 1) PG8_BAR; }
    }
    PG8_WAIT_V(0);
    if constexpr (!ALIGN_EPI) { if (wr == 0) PG8_BAR; }
    PG8_BAR;
    if constexpr (Epi::AFTER_DRAIN) { E.fused(acc, cur, wr, wc, fr, fq, lds, wid, lane); S.done(cur); }
#undef PG8_SA
#undef PG8_SB
#undef PG8_STAGE
#undef PG8_LDA
#undef PG8_LDB
#undef PG8_MMA
#undef PG8_WAIT_V
#undef PG8_WAIT_L
#undef PG8_BAR
#undef PG8_SCHED
}
}

using pg8::bf16x8; using pg8::f32x4; using pg8::u32x4; using pg8::cvt_pk_bf16;

struct Frame {
    LAS unsigned char* lds; int wave, G, gw, NGW, NGT;
    float* out; unsigned char* ws;
};
struct Args { const float* in[29]; float* out; unsigned char* ws; int ph_lo, ph_hi; };
typedef const float* cfptr;
#define CAS __attribute__((address_space(4)))
__device__ __forceinline__ const float* inp(int k) { const CAS cfptr* p = (const CAS cfptr*)__builtin_amdgcn_kernarg_segment_ptr(); asm volatile("" : "+s"(p)); return p[k]; }
__device__ __forceinline__ int tid_() { int t = threadIdx.x; asm volatile("" : "+v"(t)); return t; }
#define LANE_IDS() const int f_tid = tid_(); const int f_lane = f_tid & 63; const int f_gtid = blockIdx.x * (NWAVES * 64) + f_tid; (void)f_lane; (void)f_gtid
__device__ __forceinline__ float wave_sum(float v) {
#pragma unroll
    for (int o = 1; o < 64; o <<= 1) v += __shfl_xor(v, o);
    return v;
}
__device__ __forceinline__ float bf2f(unsigned short h) { return __uint_as_float(((unsigned)h) << 16); }
__device__ __forceinline__ void unpack8(const bf16x8 v, float* f) {
#pragma unroll
    for (int i = 0; i < 8; ++i) f[i] = bf2f((unsigned short)v[i]);
}
__device__ __forceinline__ u32x4 pack8f(const float* f) { u32x4 w; w.x = cvt_pk_bf16(f[0], f[1]); w.y = cvt_pk_bf16(f[2], f[3]); w.z = cvt_pk_bf16(f[4], f[5]); w.w = cvt_pk_bf16(f[6], f[7]); return w; }

__device__ __forceinline__ void transpose_item(const float* W, int K, int N, bf16* WT, int mode, int Hh, LAS float* scr, int item, int lane) {
    const int nblk = N / 32, kb = item / nblk, nb = item % nblk, k0 = 64 * kb, n0 = 32 * nb;
#pragma unroll 8
    for (int i = 0; i < 32; ++i) { const int kk = 2 * i + (lane >> 5); scr[kk * 33 + (lane & 31)] = W[(size_t)(k0 + kk) * N + n0 + (lane & 31)]; }
    LDS_WAIT(); asm volatile("" ::: "memory");
    int rbase = n0;
    if (mode == 1) { if (n0 < Hh) rbase = (n0 >> 7) * 256 + (n0 & 127); else { const int mm = n0 - Hh; rbase = (mm >> 7) * 256 + 128 + (mm & 127); } }
    if (mode == 2) { const int head = n0 >> 7, o = n0 & 127; rbase = (o < 64) ? 256 * (head >> 2) + 128 * (o >> 5) + 32 * (head & 3) : 1024 + 256 * (head >> 2) + 64 * (head & 3) + (o - 64); }
    const int c = lane & 7;
#pragma unroll
    for (int j = 0; j < 4; ++j) { const int n = (lane >> 3) + 8 * j; const LAS float* s = scr + (8 * c) * 33 + n;
        u32x4 o; o.x = cvt_pk_bf16(s[0 * 33], s[1 * 33]); o.y = cvt_pk_bf16(s[2 * 33], s[3 * 33]); o.z = cvt_pk_bf16(s[4 * 33], s[5 * 33]); o.w = cvt_pk_bf16(s[6 * 33], s[7 * 33]);
        *(u32x4*)(WT + (size_t)(rbase + n) * K + k0 + 8 * c) = o; }
    LDS_WAIT(); asm volatile("" ::: "memory");
}
__device__ __forceinline__ void p0a(Frame& F, const Args& A) {
    LANE_IDS();
    LAS float* scr = (LAS float*)(F.lds + F.wave * 16384);
    unsigned char* ws = F.ws;
    constexpr int I_SQ = 16 * 32, I_GLU = 16 * 64, I_FFIN = 16 * 176, I_FFOUT = 44 * 32, I_MLAIN = 16 * 25, I_QB = 8 * 48, I_KVB = 4 * 64;
    constexpr int NITEMS = 3 * I_SQ + I_GLU + 2 * I_FFIN + 2 * I_FFOUT + I_MLAIN + I_QB + I_KVB;
    for (int it = F.gw; it < NITEMS; it += F.NGW) {
        int r = it;
        if (r < I_FFIN) { transpose_item(inp(8), DM, 2 * FH, (bf16*)(ws + WS_W_FFIN0), 1, FH, scr, r, f_lane); continue; } r -= I_FFIN;
        if (r < I_FFIN) { transpose_item(inp(8) + (size_t)DM * 2 * FH, DM, 2 * FH, (bf16*)(ws + WS_W_FFIN1), 1, FH, scr, r, f_lane); continue; } r -= I_FFIN;
        if (r < I_FFOUT) { transpose_item(inp(9), FH, DM, (bf16*)(ws + WS_W_FFOUT0), 0, 0, scr, r, f_lane); continue; } r -= I_FFOUT;
        if (r < I_FFOUT) { transpose_item(inp(9) + (size_t)FH * DM, FH, DM, (bf16*)(ws + WS_W_FFOUT1), 0, 0, scr, r, f_lane); continue; } r -= I_FFOUT;
        if (r < I_GLU) { transpose_item(inp(19), DM, 2 * DM, (bf16*)(ws + WS_W_GLU), 1, DM, scr, r, f_lane); continue; } r -= I_GLU;
        if (r < I_SQ) { transpose_item(inp(10), DM, DM, (bf16*)(ws + WS_W_S5IN), 0, 0, scr, r, f_lane); continue; } r -= I_SQ;
        if (r < I_SQ) { transpose_item(inp(20), DM, DM, (bf16*)(ws + WS_W_S5OUT), 0, 0, scr, r, f_lane); continue; } r -= I_SQ;
        if (r < I_SQ) { transpose_item(inp(28), DM, DM, (bf16*)(ws + WS_W_O), 0, 0, scr, r, f_lane); continue; } r -= I_SQ;
        if (r < I_MLAIN) { transpose_item(inp(21), DM, 800, (bf16*)(ws + WS_W_MLAIN), 0, 0, scr, r, f_lane); continue; } r -= I_MLAIN;
        if (r < I_QB) { transpose_item(inp(24), QLR, NHEAD * QKD, (bf16*)(ws + WS_W_QB), 0, 0, scr, r, f_lane); continue; } r -= I_QB;
        transpose_item(inp(25), KVLR, 2048, (bf16*)(ws + WS_W_KVB), 2, 0, scr, r, f_lane);
    }
    { u32x4* z = (u32x4*)(ws + WS_W_MLAIN + (size_t)800 * DM * 2); const int nz = 224 * DM * 2 / 16;
      for (int i = f_gtid; i < nz; i += F.NGT) z[i] = (u32x4){0u, 0u, 0u, 0u}; }
    float* mod = (float*)(ws + WS_MOD);
    for (int unit = F.gw; unit < 2 * 96 * 8; unit += F.NGW) {
        const int l = unit / 768, r2 = unit % 768, cb = r2 >> 3, ks = r2 & 7, k0 = ks * 128, n = cb * 64 + f_lane;
#pragma unroll
        for (int r = 0; r < 9; ++r)
#pragma unroll
            for (int h = 0; h < 2; ++h) { const int k = k0 + h * 64 + f_lane; const float v = (r < 8) ? inp(1)[r * DM + k] : inp(3)[k]; scr[r * 128 + h * 64 + f_lane] = v * __builtin_amdgcn_rcpf(1.0f + __expf(-v)); }
        LDS_WAIT(); asm volatile("" ::: "memory");
        float acc[9];
        const float bias = (ks == 0) ? inp(5)[l * MODS + n] : 0.f;
#pragma unroll
        for (int r = 0; r < 9; ++r) acc[r] = bias;
        const float* W = inp(4) + (size_t)l * DM * MODS + (size_t)k0 * MODS + n;
#pragma unroll 8
        for (int kk = 0; kk < 128; ++kk) { const float w = W[(size_t)kk * MODS];
#pragma unroll
            for (int r = 0; r < 9; ++r) acc[r] += scr[r * 128 + kk] * w; }
#pragma unroll
        for (int r = 0; r < 9; ++r) atomicAdd(mod + (l * 9 + r) * MODS + n, acc[r]);
        LDS_WAIT(); asm volatile("" ::: "memory");
    }
    f32x2* apow = (f32x2*)(ws + WS_APOW); f32x2* bbar = (f32x2*)(ws + WS_BBAR);
    for (int i = (F.G - 1 - (int)blockIdx.x) * (NWAVES * 64) + f_tid; i < 64 * 2 * 64; i += F.NGT) {
        const int p = i & 63, dir = (i >> 6) & 1, g = i >> 7;
        const int pi = (dir * 64 + g) * 64 + p;
        const double lr = -fabs((double)inp(11)[pi]), li = (double)inp(12)[pi], dt = exp((double)inp(13)[dir * 64 + g]);
        for (int k = 0; k <= 16; ++k) { const double mag = exp(lr * dt * k), th = li * dt * k; apow[((g * 2 + dir) * 17 + k) * 64 + p] = (f32x2){(float)(mag * cos(th)), (float)(mag * sin(th))}; }
        const double mag = exp(lr * dt), ar1 = mag * cos(li * dt) - 1.0, ai = mag * sin(li * dt), den = lr * lr + li * li;
        const double cr = (ar1 * lr + ai * li) / den, ci = (ai * lr - ar1 * li) / den;
        const float* Br = inp(14) + (size_t)pi * 16; const float* Bi = inp(15) + (size_t)pi * 16;
#pragma unroll 4
        for (int c = 0; c < 16; ++c) { const double br = Br[c], bi = Bi[c]; bbar[((g * 2 + dir) * 64 + p) * 16 + c] = (f32x2){(float)(cr * br - ci * bi), (float)(cr * bi + ci * br)}; }
    }
}

template <bool SB> __device__ __forceinline__ void modnorm_rows(Frame& F, const void* src_lat, const void* src_ctx, int nrows, bf16* H, const float* gnorm, const float* modl, int shc, int scc, const float* part = nullptr, const float* pgate = nullptr, int row_begin = 0, int wave0 = 0) {
    LANE_IDS();
    if (F.gw >= wave0) for (int row = row_begin + (F.gw - wave0); row < nrows; row += F.NGW - wave0) {
        const bool isctx = row >= NLAT; const int b = isctx ? 8 : (row >> 12);
        const size_t roff = isctx ? (size_t)(row - NLAT) * DM : (size_t)row * DM; const void* sp = isctx ? src_ctx : src_lat;
        f32x4 v[4]; float ss = 0.f;
        if (SB) { const u32x2* xr = (const u32x2*)((const bf16*)sp + roff) + f_lane;
#pragma unroll
            for (int j = 0; j < 4; ++j) { const u32x2 r = xr[64 * j]; v[j] = (f32x4){__uint_as_float(r.x << 16), __uint_as_float(r.x & 0xffff0000u), __uint_as_float(r.y << 16), __uint_as_float(r.y & 0xffff0000u)}; } }
        else { const f32x4* xr = (const f32x4*)((const float*)sp + roff) + f_lane;
#pragma unroll
            for (int j = 0; j < 4; ++j) v[j] = xr[64 * j]; }
        if (part != nullptr && isctx) {
            const f32x4* p0 = (const f32x4*)(part + (size_t)(row - NLAT) * DM) + f_lane; const f32x4* p1 = p0 + (size_t)NCTX * DM / 4; const f32x4* g4p = (const f32x4*)pgate + f_lane;
#pragma unroll
            for (int j = 0; j < 4; ++j) v[j] += g4p[64 * j] * (p0[64 * j] + p1[64 * j]); }
#pragma unroll
        for (int j = 0; j < 4; ++j) ss += (v[j].x * v[j].x + v[j].y * v[j].y) + (v[j].z * v[j].z + v[j].w * v[j].w);
        const float rstd = rsqrtf(wave_sum(ss) * (1.0f / DM) + EPS);
        const f32x4* g4 = (const f32x4*)gnorm + f_lane; const f32x4* sh4 = (const f32x4*)(modl + b * MODS + shc * DM) + f_lane; const f32x4* sc4 = (const f32x4*)(modl + b * MODS + scc * DM) + f_lane;
        u32x2* o8 = (u32x2*)(H + (size_t)row * DM) + f_lane;
#pragma unroll
        for (int j = 0; j < 4; ++j) { const f32x4 y = v[j] * rstd * g4[64 * j] * (sc4[64 * j] + 1.0f) + sh4[64 * j];
            u32x2 w; w.x = cvt_pk_bf16(y.x, y.y); w.y = cvt_pk_bf16(y.z, y.w); o8[64 * j] = w; }
    }
}

__device__ __forceinline__ void p0b_tables(Frame& F, const Args& A, int t0) {
    LANE_IDS();
    const int tg = f_gtid - t0, tn = F.NGT - t0; if (tg < 0) return;
    unsigned char* ws = F.ws;
    const f32x2* apow = (const f32x2*)(ws + WS_APOW); const f32x2* bbar = (const f32x2*)(ws + WS_BBAR);
    float* Kc = (float*)(ws + WS_KC); bf16* WBT = (bf16*)(ws + WS_WBT); bf16* TBT = (bf16*)(ws + WS_TBT);
    const float* Cre = inp(16); const float* Cim = inp(17);
    for (int i = tg; i < 64 * 2 * 16 * 256; i += tn) {
        const int c = i & 15, cp = (i >> 4) & 15, k = (i >> 8) & 15, dir = (i >> 12) & 1, g = i >> 13;
        const f32x2* ap = apow + ((g * 2 + dir) * 17 + k) * 64; const f32x2* bb = bbar + (size_t)((g * 2 + dir) * 64) * 16 + c;
        const float* cr = Cre + ((size_t)(dir * 64 + g) * 16 + cp) * 64; const float* ci = Cim + ((size_t)(dir * 64 + g) * 16 + cp) * 64;
        float s = 0.f;
        for (int p = 0; p < 64; ++p) { const f32x2 a = ap[p], b = bb[p * 16]; const float xr = a.x * b.x - a.y * b.y, xi = a.x * b.y + a.y * b.x; s += cr[p] * xr - ci[p] * xi; }
        Kc[i] = s;
    }
    for (int i = tg; i < 64 * 256 * 32; i += tn) {
        const int c8 = i & 1, s = (i >> 1) & 15, n = (i >> 5) & 255, g = i >> 13, dir = n >> 7, comp = n & 127, p = comp & 63, im = comp >> 6;
        const f32x2 a = apow[((g * 2 + dir) * 17 + (dir ? s : 15 - s)) * 64 + p]; const f32x2* bb = bbar + (size_t)((g * 2 + dir) * 64 + p) * 16 + c8 * 8;
        float o[8];
#pragma unroll
        for (int j = 0; j < 8; ++j) { const f32x2 b = bb[j]; o[j] = im ? (a.x * b.y + a.y * b.x) : (a.x * b.x - a.y * b.y); }
        *(u32x4*)(WBT + ((size_t)(g * 256 + n) * 256 + s * 16 + c8 * 8)) = pack8f(o);
    }
    for (int i = tg; i < 64 * 256 * 32; i += tn) {
        const int q8 = i & 31, n = (i >> 5) & 255, g = i >> 13, tau = n >> 4, cp = n & 15, dir = q8 >> 4, comp0 = (q8 & 15) * 8, im = comp0 >> 6, p0 = comp0 & 63;
        const f32x2* ap = apow + ((g * 2 + dir) * 17 + (dir ? 16 - tau : tau + 1)) * 64 + p0;
        const float* cr = Cre + ((size_t)(dir * 64 + g) * 16 + cp) * 64 + p0; const float* ci = Cim + ((size_t)(dir * 64 + g) * 16 + cp) * 64 + p0;
        float o[8];
#pragma unroll
        for (int j = 0; j < 8; ++j) { const f32x2 a = ap[j]; o[j] = im ? -(cr[j] * a.y + ci[j] * a.x) : (cr[j] * a.x - ci[j] * a.y); }
        *(u32x4*)(TBT + ((size_t)(g * 256 + n) * 512 + 256 + dir * 128 + comp0)) = pack8f(o);
    }
}

__device__ __forceinline__ void p3_scan(Frame& F, const Args& A) {
    LANE_IDS();
    unsigned char* ws = F.ws;
    const f32x2* apow = (const f32x2*)(ws + WS_APOW); const float* Kc = (const float*)(ws + WS_KC); bf16* TBT = (bf16*)(ws + WS_TBT);
    const float* E = (const float*)(ws + WS_X); bf16* ACAT = (bf16*)(ws + WS_ACAT);
#define SCAN_K(seg, j) (dir ? ((seg) == 0 ? 15 - (j) : 271 - 16 * ((seg) - 1) - (j)) : 16 * (seg) + (j))
#define SCAN_LOAD(ER, EI, seg) do { _Pragma("unroll") for (int j = 0; j < 16; ++j) { const int k = SCAN_K(seg, j); ER[j] = Eb[(size_t)k * 256]; EI[j] = Eb[(size_t)k * 256 + 64]; } } while (0)
#define SCAN_STEP(ER, EI, seg) do { _Pragma("unroll") for (int j = 0; j < 16; ++j) { const int k = SCAN_K(seg, j); \
        Hb[(size_t)k * 512] = (bf16)(cvt_pk_bf16(hr, 0.f) & 0xffffu); Hb[(size_t)k * 512 + 64] = (bf16)(cvt_pk_bf16(hi, 0.f) & 0xffffu); \
        const float nr = a16.x * hr - a16.y * hi + ER[j], ni = a16.x * hi + a16.y * hr + EI[j]; hr = nr; hi = ni; } } while (0)
    if (F.wave < 4) for (int u = (int)blockIdx.x * 4 + F.wave; u < 64 * 8 * 2; u += F.G * 4) {
        const int dir = u & 1, b = (u >> 1) & 7, g = u >> 4, p = f_lane;
        const f32x2 a16 = apow[((g * 2 + dir) * 17 + 16) * 64 + p];
        const float* Eb = E + ((size_t)g * GROWS + b * NCH) * 256 + dir * 128 + p;
        bf16* Hb = ACAT + ((size_t)(g * GPAD + b * NCH)) * 512 + 256 + dir * 128 + p;
        float hr = 0.f, hi = 0.f;
        float er0[16], ei0[16], er1[16], ei1[16];
        SCAN_LOAD(er0, ei0, 0);
        for (int seg = 0; seg < 17; seg += 2) {
            if (seg + 1 < 17) SCAN_LOAD(er1, ei1, seg + 1);
            SCAN_STEP(er0, ei0, seg);
            if (seg + 1 < 17) { if (seg + 2 < 17) SCAN_LOAD(er0, ei0, seg + 2); SCAN_STEP(er1, ei1, seg + 1); }
        }
    }
#undef SCAN_K
#undef SCAN_LOAD
#undef SCAN_STEP
    const float* Dk = inp(18);
    for (int i = f_gtid; i < 64 * 256 * 32; i += F.NGT) {
        const int c8 = i & 1, s = (i >> 1) & 15, n = (i >> 5) & 255, g = i >> 13, tau = n >> 4, cp = n & 15;
        float o[8];
#pragma unroll
        for (int j = 0; j < 8; ++j) o[j] = 0.f;
        if (s <= tau) { const float* kf = Kc + ((size_t)((g * 2 + 0) * 16 + (tau - s)) * 16 + cp) * 16 + c8 * 8;
#pragma unroll
            for (int j = 0; j < 8; ++j) o[j] += kf[j]; }
        if (s >= tau) { const float* kb = Kc + ((size_t)((g * 2 + 1) * 16 + (s - tau)) * 16 + cp) * 16 + c8 * 8;
#pragma unroll
            for (int j = 0; j < 8; ++j) o[j] += kb[j]; }
        if (s == tau) { const float dv = Dk[g * 16 + cp];
#pragma unroll
            for (int j = 0; j < 8; ++j) if (c8 * 8 + j == cp) o[j] += dv; }
        *(u32x4*)(TBT + ((size_t)(g * 256 + n) * 512 + s * 16 + c8 * 8)) = pack8f(o);
    }
}

__device__ __forceinline__ void p12_lrnorm(Frame& F, const Args& A) {
    LANE_IDS();
    unsigned char* ws = F.ws;
    const bf16* PX = (const bf16*)(ws + WS_PX); bf16* QL = (bf16*)((unsigned char*)F.out + OUT_QL); bf16* CKV = (bf16*)(ws + WS_CKV); bf16* KPE = (bf16*)(ws + WS_KPE);
    const float* gqa = inp(22); const float* gkva = inp(23);
    for (int row = F.gw; row < NTOK; row += F.NGW) {
        const bf16* pr = PX + (size_t)row * DM;
        if (row < NLAT) {
            float q[8]; unpack8(*(const bf16x8*)(pr + 8 * f_lane), q); float ss = 0.f;
#pragma unroll
            for (int j = 0; j < 8; ++j) ss += q[j] * q[j];
            const float rstd = rsqrtf(wave_sum(ss) * (1.0f / QLR) + EPS);
#pragma unroll
            for (int j = 0; j < 8; ++j) q[j] = q[j] * rstd * gqa[8 * f_lane + j];
            *(u32x4*)(QL + (size_t)row * QLR + 8 * f_lane) = pack8f(q);
        }
        { const u32x2 raw = *(const u32x2*)(pr + QLR + 4 * f_lane); float k[4];
          k[0] = __uint_as_float(raw.x << 16); k[1] = __uint_as_float(raw.x & 0xffff0000u); k[2] = __uint_as_float(raw.y << 16); k[3] = __uint_as_float(raw.y & 0xffff0000u);
          const float ss = (k[0] * k[0] + k[1] * k[1]) + (k[2] * k[2] + k[3] * k[3]);
          const float rstd = rsqrtf(wave_sum(ss) * (1.0f / KVLR) + EPS);
          const f32x4 gg = *(const f32x4*)(gkva + 4 * f_lane);
          u32x2 w; w.x = cvt_pk_bf16(k[0] * rstd * gg.x, k[1] * rstd * gg.y); w.y = cvt_pk_bf16(k[2] * rstd * gg.z, k[3] * rstd * gg.w);
          *(u32x2*)(CKV + (size_t)row * KVLR + 4 * f_lane) = w; }
        if (f_lane < 4) *(u32x4*)(KPE + (size_t)row * 32 + 8 * f_lane) = *(const u32x4*)(pr + QLR + KVLR + 8 * f_lane);
    }
}

__device__ __forceinline__ void head_norm_rope_store(const bf16x8 (&raw)[12], const float* gw, bool rope, int l, bf16* dst, float oscale) {
    float ss = 0.f;
#pragma unroll
    for (int j = 0; j < 12; ++j) { float t[8]; unpack8(raw[j], t);
#pragma unroll
        for (int e = 0; e < 8; ++e) ss += t[e] * t[e]; }
    const float rstd = rsqrtf(ss * (1.0f / 96.0f) + EPS) * oscale;
#pragma unroll
    for (int j = 0; j < 8; ++j) { float t[8]; unpack8(raw[j], t);
#pragma unroll
        for (int e = 0; e < 8; ++e) t[e] = t[e] * rstd * gw[8 * j + e];
        *(u32x4*)(dst + 8 * j) = pack8f(t); }
    const float invf[8] = {1.0f, 0.31622776601683794f, 0.1f, 0.031622776601683794f, 0.01f, 0.0031622776601683794f, 0.001f, 0.00031622776601683794f};
#pragma unroll
    for (int ax = 0; ax < 2; ++ax) { float x1[8], x2[8]; unpack8(raw[8 + 2 * ax], x1); unpack8(raw[9 + 2 * ax], x2);
        const float pos = ax ? (float)(l & 63) : (float)(l >> 6);
#pragma unroll
        for (int e = 0; e < 8; ++e) { const float a = x1[e] * rstd * gw[64 + 16 * ax + e], b = x2[e] * rstd * gw[72 + 16 * ax + e];
            float cs = 1.f, sn = 0.f; if (rope) { const float ang = pos * invf[e]; cs = __cosf(ang); sn = __sinf(ang); }
            x1[e] = a * cs - b * sn; x2[e] = b * cs + a * sn; }
        *(u32x4*)(dst + 64 + 16 * ax) = pack8f(x1); *(u32x4*)(dst + 72 + 16 * ax) = pack8f(x2); }
}
__device__ __forceinline__ void p15_prep(Frame& F, const Args& A) {
    LANE_IDS();
    unsigned char* ws = F.ws;
    const bf16* KN = (const bf16*)(ws + WS_H); const bf16* KPE = (const bf16*)(ws + WS_KPE); bf16* KH = (bf16*)(ws + WS_KH);
    const float* gk = inp(27);
    for (int i = f_gtid; i < NTOK * NHEAD; i += F.NGT) {
        const int row = i >> 4, h = i & 15; const bf16* kn = KN + (size_t)row * DM + h * 64; const bf16* kp = KPE + (size_t)row * 32;
        bf16x8 raw[12];
#pragma unroll
        for (int j = 0; j < 8; ++j) raw[j] = *(const bf16x8*)(kn + 8 * j);
#pragma unroll
        for (int j = 0; j < 4; ++j) raw[8 + j] = *(const bf16x8*)(kp + 8 * j);
        int b, sp; pg8::row_to_bsp(row, b, sp);
        bf16* kd = KH + ((size_t)(b * NHEAD + h) * SPB + sp) * 128;
        head_norm_rope_store(raw, gk, row < NLAT, row & (SEQ - 1), kd, 1.0f);
        *(u32x4*)(kd + 96) = (u32x4){0x3F80u, 0u, 0u, 0u}; *(u32x4*)(kd + 104) = (u32x4){0u, 0u, 0u, 0u};
    }
}

namespace att {
using s16x4  = __attribute__((ext_vector_type(4))) short;
using f32x16 = __attribute__((ext_vector_type(16))) float;
constexpr int NW = 8, QBLK = 32, KVBLK = 64;
constexpr float SCALE = 0.10206207261596575f;
constexpr float THR = 8.f;
constexpr int LDQ = NHEAD * QKD, LDK = 128, LDV = VD, LDO = DM;
constexpr size_t SHM_V = KVBLK * 128 * 2, SHM_K = KVBLK * 128 * 2, SHM_ATTN = 3 * SHM_V + 3 * SHM_K + NW * 64 * 4;
#define KSWZ(row, colB) ((row) * 256 + ((colB) ^ (((row) & 7) << 4)))
#define SBAR() __builtin_amdgcn_sched_barrier(0)
__device__ __forceinline__ int crow(int r, int hi) { return (r & 3) + 8 * (r >> 2) + 4 * hi; }
__device__ __forceinline__ unsigned cvtpk(float lo, float hi) { unsigned r; asm volatile("v_cvt_pk_bf16_f32 %0, %1, %2" : "=v"(r) : "v"(lo), "v"(hi)); return r; }
__device__ __forceinline__ void partialSM(f32x16& p0) {
#pragma unroll
  for (int r = 0; r < 16; ++r) p0[r] = __builtin_amdgcn_exp2f(p0[r]);
}
__device__ __forceinline__ void finishSM(f32x16& p0, f32x16& p1, float& l_reg, bf16x8& pa0, bf16x8& pa1, bf16x8& pa2, bf16x8& pa3) {
#pragma unroll
  for (int r = 0; r < 16; ++r) p1[r] = __builtin_amdgcn_exp2f(p1[r]);
  float ps = 0;
#pragma unroll
  for (int r = 0; r < 16; ++r) ps += p0[r];
#pragma unroll
  for (int r = 0; r < 16; ++r) ps += p1[r];
  l_reg += ps;
#define PK4(P, BASE, OUT) do { unsigned a0 = cvtpk(P[BASE + 0], P[BASE + 1]), a1 = cvtpk(P[BASE + 2], P[BASE + 3]);   \
    unsigned b0 = cvtpk(P[BASE + 4], P[BASE + 5]), b1 = cvtpk(P[BASE + 6], P[BASE + 7]);                              \
    auto r0 = __builtin_amdgcn_permlane32_swap(a0, b0, false, false); auto r1 = __builtin_amdgcn_permlane32_swap(a1, b1, false, false); \
    u32x4 w = {r0[0], r1[0], r0[1], r1[1]}; OUT = *reinterpret_cast<bf16x8*>(&w); } while (0)
  PK4(p0, 0, pa0); PK4(p0, 8, pa1); PK4(p1, 0, pa2); PK4(p1, 8, pa3);
#undef PK4
}
template <int ND> __device__ __forceinline__ void qkt(f32x16& p0, f32x16& p1, const bf16* Ks, const bf16x8* qr, int r32, int hi) {
  p0 = f32x16{}; p1 = f32x16{};
  __builtin_amdgcn_s_setprio(1);
#pragma unroll
  for (int d0 = 0; d0 < ND; ++d0) { int cb = (d0 * 16 + hi * 8) * 2;
    bf16x8 b0 = *reinterpret_cast<const bf16x8*>((const char*)Ks + KSWZ(r32, cb));
    bf16x8 b1 = *reinterpret_cast<const bf16x8*>((const char*)Ks + KSWZ(32 + r32, cb));
    p0 = __builtin_amdgcn_mfma_f32_32x32x16_bf16(b0, qr[d0], p0, 0, 0, 0);
    p1 = __builtin_amdgcn_mfma_f32_32x32x16_bf16(b1, qr[d0], p1, 0, 0, 0); }
  __builtin_amdgcn_s_setprio(0);
}
__device__ __forceinline__ int v_st(int k, int c) { const int kk = (k & ~0xC) | ((k & 4) << 1) | ((k & 8) >> 1); return ((kk >> 3) * 4 + (c >> 5)) * 512 + ((kk & 7) * 32 + (c & 31)) * 2; }
__device__ __forceinline__ int v_rd_base(int lane) { return ((lane & 3) << 3) | (((lane >> 2) & 3) << 6) | (((lane >> 4) & 1) << 5) | (((lane >> 5) & 1) << 8); }
constexpr int v_rd_off(int d0, int ks, int half) { return d0 * 512 + ks * 4096 + half * 2048; }
template <int OFF> __device__ __forceinline__ s16x4 tr_read(int vb) {
  s16x4 r; asm volatile("ds_read_b64_tr_b16 %0, %1 offset:%2" : "=&v"(r) : "v"(vb), "i"(OFF) : "memory"); return r;
}
template <int D0> __device__ __forceinline__ void pv_one(f32x16& od, int vb, bf16x8 pa0, bf16x8 pa1, bf16x8 pa2, bf16x8 pa3) {
  const s16x4 l0 = tr_read<v_rd_off(D0, 0, 0)>(vb), h0 = tr_read<v_rd_off(D0, 0, 1)>(vb), l1 = tr_read<v_rd_off(D0, 1, 0)>(vb), h1 = tr_read<v_rd_off(D0, 1, 1)>(vb);
  const s16x4 l2 = tr_read<v_rd_off(D0, 2, 0)>(vb), h2 = tr_read<v_rd_off(D0, 2, 1)>(vb), l3 = tr_read<v_rd_off(D0, 3, 0)>(vb), h3 = tr_read<v_rd_off(D0, 3, 1)>(vb);
  asm volatile("s_waitcnt lgkmcnt(0)" ::: "memory"); SBAR();
#define PK(L, H) (bf16x8){L[0], L[1], L[2], L[3], H[0], H[1], H[2], H[3]}
  __builtin_amdgcn_s_setprio(1);
  od = __builtin_amdgcn_mfma_f32_32x32x16_bf16(pa0, PK(l0, h0), od, 0, 0, 0);
  od = __builtin_amdgcn_mfma_f32_32x32x16_bf16(pa1, PK(l1, h1), od, 0, 0, 0);
  od = __builtin_amdgcn_mfma_f32_32x32x16_bf16(pa2, PK(l2, h2), od, 0, 0, 0);
  od = __builtin_amdgcn_mfma_f32_32x32x16_bf16(pa3, PK(l3, h3), od, 0, 0, 0);
  __builtin_amdgcn_s_setprio(0);
#undef PK
}
__device__ __forceinline__ void pv_d0(f32x16* o, int vb, bf16x8 pa0, bf16x8 pa1, bf16x8 pa2, bf16x8 pa3) {
  pv_one<0>(o[0], vb, pa0, pa1, pa2, pa3); pv_one<1>(o[1], vb, pa0, pa1, pa2, pa3);
}
template <bool SHIFT> __device__ __forceinline__ void attn_dense_body(const bf16* __restrict__ Qb, const bf16* __restrict__ Kh, const bf16* __restrict__ Vh, bf16* __restrict__ Ob, int seq, char* lds, LAS unsigned char* ldsl, float negB, const float* __restrict__ gq, int qpos0) {
  const int tid = threadIdx.x, wid = tid >> 6, lane = tid & 63, r32 = lane & 31, hi = lane >> 5;
  bf16* V_lds = (bf16*)lds; bf16* K_lds = (bf16*)(lds + 3 * SHM_V);
  float* wsf = (float*)(lds + 3 * SHM_V + 3 * SHM_K) + wid * 64; float* li_l = wsf;
  float l_reg = 0; f32x16 o[2] = {}; bf16x8 qr[7];
  const bf16* Qw = Qb + (long)(wid * QBLK + r32) * LDQ + hi * 8;
  asm volatile("" : "+s"(gq));
  { float ss = 0.f;
#pragma unroll
    for (int d0 = 0; d0 < 6; ++d0) { qr[d0] = *reinterpret_cast<const bf16x8*>(Qw + d0 * 16);
#pragma unroll
      for (int e = 0; e < 8; ++e) { const float f = __uint_as_float(((unsigned)(unsigned short)qr[d0][e]) << 16); ss += f * f; } }
    { auto rr = __builtin_amdgcn_permlane32_swap(__float_as_uint(ss), __float_as_uint(ss), false, false); ss = __uint_as_float(rr[0]) + __uint_as_float(rr[1]); }
    const float rstd = rsqrtf(ss * (1.0f / 96.0f) + EPS) * (SCALE * 1.4426950408889634f);
    int lpos = qpos0 + wid * QBLK + r32; asm volatile("" : "+v"(lpos));
    const float invf[8] = {1.0f, 0.31622776601683794f, 0.1f, 0.031622776601683794f, 0.01f, 0.0031622776601683794f, 0.001f, 0.00031622776601683794f};
#pragma unroll
    for (int d0 = 0; d0 < 6; ++d0) { float f[8];
      const f32x4 g0 = *reinterpret_cast<const f32x4*>(gq + d0 * 16 + hi * 8), g1 = *reinterpret_cast<const f32x4*>(gq + d0 * 16 + hi * 8 + 4);
#pragma unroll
      for (int e = 0; e < 8; ++e) f[e] = __uint_as_float(((unsigned)(unsigned short)qr[d0][e]) << 16) * rstd * (e < 4 ? g0[e & 3] : g1[e & 3]);
      if (d0 >= 4) { const float pos = (d0 == 5) ? (float)(lpos & 63) : (float)(lpos >> 6);
#pragma unroll
        for (int e = 0; e < 8; ++e) { const float own = f[e];
          auto rr = __builtin_amdgcn_permlane32_swap(__float_as_uint(own), __float_as_uint(own), false, false);
          const float other = hi ? __uint_as_float(rr[0]) : __uint_as_float(rr[1]);
          const float ang = pos * invf[e], cs = __cosf(ang), sn = __sinf(ang);
          f[e] = own * cs + (hi ? other : -other) * sn; } }
      u32x4 w = pack8f(f); qr[d0] = *reinterpret_cast<bf16x8*>(&w);
      asm volatile("" : "+v"(qr[d0])); }
  }
  { u32x4 w = {hi == 0 ? (cvtpk(negB, 0.f) & 0xffffu) : 0u, 0u, 0u, 0u}; qr[6] = *reinterpret_cast<bf16x8*>(&w); }
  const int vb0 = (int)(uintptr_t)V_lds + v_rd_base(lane);
  const int widu = __builtin_amdgcn_readfirstlane(wid);
  const int kr0 = 8 * wid + (lane >> 4), kr1 = kr0 + 4, kp = lane & 15;
  const int vkk = 8 * wid + ((lane & 31) >> 2), vk = (vkk & ~0xC) | ((vkk & 4) << 1) | ((vkk & 8) >> 1), vcc = 32 * (lane >> 5) + 8 * (lane & 3);
  const bf16* kg0 = Kh + (long)kr0 * LDK + ((kp ^ (kr0 & 7)) * 8); const bf16* kg1 = Kh + (long)kr1 * LDK + ((kp ^ (kr1 & 7)) * 8); const bf16* vg = Vh + (long)vk * LDV + vcc;
  LAS unsigned char* const lV = ldsl; LAS unsigned char* const lK = ldsl + 3 * SHM_V;
#define DMA(b, k0) do { \
    __builtin_amdgcn_global_load_lds((const unsigned*)(kg0 + (long)(k0) * LDK), (LAS unsigned*)(lK + (b) * (int)SHM_K + (2 * widu) * 1024), 16, 0, 0); \
    __builtin_amdgcn_global_load_lds((const unsigned*)(kg1 + (long)(k0) * LDK), (LAS unsigned*)(lK + (b) * (int)SHM_K + (2 * widu + 1) * 1024), 16, 0, 0); \
    __builtin_amdgcn_global_load_lds((const unsigned*)(vg + (long)(k0) * LDV), (LAS unsigned*)(lV + (b) * (int)SHM_V + (4 * widu) * 512), 16, 0, 0); } while (0)
  f32x16 pA0, pA1, pB0, pB1; bf16x8 pa0, pa1, pa2, pa3; const int NT = seq / KVBLK;
  DMA(0, 0); asm volatile("s_waitcnt vmcnt(0)" ::: "memory"); __syncthreads();
  DMA(1, KVBLK);
  qkt<SHIFT ? 7 : 6>(pA0, pA1, K_lds, qr, r32, hi); partialSM(pA0);
  asm volatile("s_waitcnt vmcnt(0)" ::: "memory"); __syncthreads();
  int bv = 0, bk = 1, bw = 2;
#define ROT() do { const int t_ = bv; bv = bk; bk = bw; bw = t_; } while (0)
  for (int j = 1; j + 1 < NT; j += 2) {
    DMA(bw, (j + 1) * KVBLK);
    SBAR(); qkt<SHIFT ? 7 : 6>(pB0, pB1, (bf16*)((char*)K_lds + bk * SHM_K), qr, r32, hi);
    finishSM(pA0, pA1, l_reg, pa0, pa1, pa2, pa3); SBAR();
    pv_d0(o, vb0 + bv * (int)SHM_V, pa0, pa1, pa2, pa3); partialSM(pB0);
    asm volatile("s_waitcnt vmcnt(0)" ::: "memory"); __syncthreads(); ROT();
    DMA(bw, (j + 2) * KVBLK);
    SBAR(); qkt<SHIFT ? 7 : 6>(pA0, pA1, (bf16*)((char*)K_lds + bk * SHM_K), qr, r32, hi);
    finishSM(pB0, pB1, l_reg, pa0, pa1, pa2, pa3); SBAR();
    pv_d0(o, vb0 + bv * (int)SHM_V, pa0, pa1, pa2, pa3); partialSM(pA0);
    asm volatile("s_waitcnt vmcnt(0)" ::: "memory"); __syncthreads(); ROT();
  }
  SBAR(); qkt<SHIFT ? 7 : 6>(pB0, pB1, (bf16*)((char*)K_lds + bk * SHM_K), qr, r32, hi);
  finishSM(pA0, pA1, l_reg, pa0, pa1, pa2, pa3); SBAR();
  pv_d0(o, vb0 + bv * (int)SHM_V, pa0, pa1, pa2, pa3); partialSM(pB0);
  ROT();
  finishSM(pB0, pB1, l_reg, pa0, pa1, pa2, pa3); SBAR();
  pv_d0(o, vb0 + bv * (int)SHM_V, pa0, pa1, pa2, pa3);
#undef ROT
#undef DMA
  { auto rr = __builtin_amdgcn_permlane32_swap(__float_as_uint(l_reg), __float_as_uint(l_reg), false, false); l_reg = __uint_as_float(rr[0]) + __uint_as_float(rr[1]); }
  if (hi == 0) li_l[r32] = l_reg; asm volatile("s_waitcnt lgkmcnt(0)" ::: "memory");
  float rli[16];
#pragma unroll
  for (int r = 0; r < 16; ++r) rli[r] = __builtin_amdgcn_rcpf(li_l[crow(r, hi)]);
  bf16* Ow = Ob + (long)(wid * QBLK) * LDO;
#pragma unroll
  for (int r = 0; r < 16; ++r) { int orow = crow(r, hi);
#pragma unroll
    for (int d0 = 0; d0 < 2; ++d0) Ow[(long)orow * LDO + d0 * 32 + r32] = (bf16)(cvtpk(o[d0][r] * rli[r], 0.f) & 0xffffu); }
  __syncthreads();
}
}

#define XB_TMO      128
#define XB_XCNT(j)  (256  + 64 * (j))
#define XB_XSUB(j)  (1280 + 64 * (j))
#define XB_XGEN(j)  (2304 + 64 * (j))
#define XB_TOP      3328
#define XB_TOPGEN   3392
#define XCD_BAR_WORDS 3456
#define XB_SPIN_CAP (1u << 18)

__device__ __forceinline__ unsigned xb_ld(unsigned* p)              { return __hip_atomic_load(p, __ATOMIC_RELAXED, __HIP_MEMORY_SCOPE_AGENT); }
__device__ __forceinline__ unsigned xb_add(unsigned* p, unsigned v) { return __hip_atomic_fetch_add(p, v, __ATOMIC_RELAXED, __HIP_MEMORY_SCOPE_AGENT); }
__device__ __forceinline__ unsigned xb_xcc_id() { return (unsigned)__builtin_amdgcn_s_getreg((3 << 11) | 20) & 0xFu; }
#define XB_SPIN(cond, bar) do { unsigned _sp = 0; while (cond) { __builtin_amdgcn_s_sleep(1); \
    if ((++_sp & 255u) == 0u) { if (xb_ld(&(bar)[XB_TMO])) break; if (_sp > XB_SPIN_CAP) { atomicAdd(&(bar)[XB_TMO], 1u); break; } } } } while (0)

struct XcdBarrier {
    unsigned* bar; unsigned x;
    volatile LAS unsigned* st;
};

__device__ __forceinline__ XcdBarrier xcd_barrier_post(unsigned* bar, volatile LAS unsigned* st) {
    XcdBarrier b; b.bar = bar; b.x = xb_xcc_id(); b.st = st;
    if (threadIdx.x == 0) (void)xb_add(&bar[XB_XCNT(b.x)], 1u);
    return b;
}
__device__ __forceinline__ void xcd_barrier_complete(unsigned* bar, unsigned x, unsigned& nloc, unsigned& nx) {
    const unsigned G = gridDim.x * gridDim.y * gridDim.z;
    unsigned sum, cnt, mine, sp = 0u;
    for (;;) {
        sum = 0u; cnt = 0u; mine = 0u;
#pragma unroll
        for (unsigned j = 0; j < 16; ++j) { const unsigned c = xb_ld(&bar[XB_XCNT(j)]); sum += c; cnt += (c > 0u) ? 1u : 0u; mine = (j == x) ? c : mine; }
        if (sum == G) break;
        __builtin_amdgcn_s_sleep(1);
        if ((++sp & 255u) == 0u) { if (xb_ld(&bar[XB_TMO])) break; if (sp > XB_SPIN_CAP) { atomicAdd(&bar[XB_TMO], 1u); break; } }
    }
    nloc = mine > 0u ? mine : 1u; nx = cnt > 0u ? cnt : 1u;
}

__device__ __forceinline__ void xcd_barrier(const XcdBarrier& b) {
    asm volatile("s_waitcnt vmcnt(0)" ::: "memory");
    __syncthreads();
    if (threadIdx.x == 0) {
        unsigned* bar = b.bar;
        __builtin_amdgcn_s_waitcnt(0);
        unsigned nloc = b.st[0], nx = b.st[1];
        if (nloc == 0u) { xcd_barrier_complete(bar, b.x, nloc, nx); b.st[0] = nloc; b.st[1] = nx; }
        const unsigned old = xb_add(&bar[XB_XSUB(b.x)], 1u);
        const unsigned gen = old / nloc;
        if (old + 1u == (gen + 1u) * nloc) {
            __builtin_amdgcn_fence(__ATOMIC_RELEASE, "agent");
            asm volatile("s_waitcnt vmcnt(0)" ::: "memory");
            const unsigned og = xb_add(&bar[XB_TOP], 1u);
            const unsigned tg = og / nx;
            if (og + 1u == (tg + 1u) * nx) xb_add(&bar[XB_TOPGEN], 1u);
            else XB_SPIN(xb_ld(&bar[XB_TOPGEN]) == tg, bar);
            __builtin_amdgcn_fence(__ATOMIC_ACQUIRE, "agent");
            xb_add(&bar[XB_XGEN(b.x)], 1u);
            asm volatile("s_waitcnt vmcnt(0)" ::: "memory");
        } else {
            XB_SPIN(xb_ld(&bar[XB_XGEN(b.x)]) == gen, bar);
            __builtin_amdgcn_fence(__ATOMIC_ACQUIRE, "agent");
            asm volatile("s_waitcnt vmcnt(0)" ::: "memory");
        }
    }
    __syncthreads();
}


constexpr int NPHASE = 21;
__device__ __forceinline__ const CAS Args* kargs() { const CAS Args* p = (const CAS Args*)__builtin_amdgcn_kernarg_segment_ptr(); asm volatile("" : "+s"(p)); return p; }
__global__ void __launch_bounds__(NWAVES * 64, 2) mk_fwd(Args args) {
    extern __shared__ __attribute__((aligned(16))) unsigned char lds[];
    cg::grid_group grid = cg::this_grid();
    Frame F;
    F.lds = (LAS unsigned char*)lds;
    F.wave = __builtin_amdgcn_readfirstlane((int)threadIdx.x >> 6);
    F.G = gridDim.x; F.gw = blockIdx.x * NWAVES + F.wave; F.NGW = F.G * NWAVES; F.NGT = F.G * NWAVES * 64;
#ifndef PH_MASK
#define PH_MASK 0xffffffffu
#endif
#define IN(k) ((((PH_MASK) >> (k)) & 1u) && kargs()->ph_lo <= (k) && (k) < kargs()->ph_hi)
#ifndef PROBE_REP_MASK
#define PROBE_REP_MASK 0u
#endif
#define PH_REPS(k) ((((PROBE_REP_MASK) >> (k)) & 1u) ? 2 : 1)
#define SEAM(k) do { if (IN((k) + 1)) xcd_barrier(xbar); } while (0)
#define PH_PTRS() unsigned char* ws = kargs()->ws; F.ws = ws; F.out = kargs()->out; float* mod = (float*)(ws + WS_MOD); const float* mod1 = mod + 9 * MODS; bf16* X = (bf16*)(ws + WS_X);     bf16* H = (bf16*)(ws + WS_H); (void)mod; (void)mod1; (void)X; (void)H
    const int bx = blockIdx.x;
    volatile LAS unsigned* bst = (volatile LAS unsigned*)(F.lds + 131072 + 64);
    if (threadIdx.x == 0) { bst[0] = 0u; bst[1] = 0u; }
    __syncthreads();
    const XcdBarrier xbar = xcd_barrier_post((unsigned*)(kargs()->ws + WS_BAR), bst);
    if (kargs()->ph_hi > 1000) grid.sync();
#if defined(PROBE_SYNCS)
    if (kargs()->ph_hi - kargs()->ph_lo > 1) for (int i = 0; i < PROBE_SYNCS; ++i) xcd_barrier(xbar);
#endif

    if (IN(0)) for (int rep_ = 0; rep_ < PH_REPS(0); ++rep_) { PH_PTRS(); p0a(F, args); if (rep_ == PH_REPS(0) - 1) SEAM(0); }
    if (IN(1)) for (int rep_ = 0; rep_ < PH_REPS(1); ++rep_) { PH_PTRS(); modnorm_rows<false>(F, inp(0), inp(2), NTOK, H, inp(6), mod, 0, 1); if (rep_ == PH_REPS(1) - 1) SEAM(1); }
    const int NCB0 = (F.G >= 128) ? 32 : 0;
    if (IN(2)) for (int rep_ = 0; rep_ < PH_REPS(2); ++rep_) { PH_PTRS();
        { pg8::Gemm g{H, (const bf16*)(ws + WS_W_S5IN), NLAT, DM, DM, DM}; pg8::StaticOrder S; S.init(NLAT, DM, F.G, bx);
          pg8::EpiU E{(bf16*)(ws + WS_ACAT)};
          pg8::gemm_phase<pg8::EpiU, pg8::StaticOrder, true, true>(F.lds, g, S, E); }
        if (bx < NCB0 || NCB0 == 0) {
            pg8::Gemm g{H + (size_t)NLAT * DM, (const bf16*)(ws + WS_W_S5IN), NCTX, DM, DM, DM}; pg8::StaticOrder S; S.init(NCTX, DM, F.G, bx);
            pg8::EpiU E{(bf16*)(ws + WS_ACAT), 128};
            pg8::gemm_phase<pg8::EpiU, pg8::StaticOrder, true, true>(F.lds, g, S, E); }
        if (bx >= NCB0) p0b_tables(F, args, NCB0 * NWAVES * 64);
        if (rep_ == PH_REPS(2) - 1) SEAM(2); }
    if (IN(3)) for (int rep_ = 0; rep_ < PH_REPS(3); ++rep_) { PH_PTRS();
        pg8::Gemm g{(const bf16*)(ws + WS_ACAT), (const bf16*)(ws + WS_WBT), 64 * GPAD, 64 * 256, 256, 512}; pg8::GroupOrder S{F.G, bx};
        pg8::EpiE E{(float*)(ws + WS_X)};
        pg8::gemm_phase<pg8::EpiE, pg8::GroupOrder, true, true>(F.lds, g, S, E); if (rep_ == PH_REPS(3) - 1) SEAM(3); }
    if (IN(4)) for (int rep_ = 0; rep_ < PH_REPS(4); ++rep_) { PH_PTRS(); p3_scan(F, args); if (rep_ == PH_REPS(4) - 1) SEAM(4); }
    if (IN(5)) for (int rep_ = 0; rep_ < PH_REPS(5); ++rep_) { PH_PTRS();
        pg8::Gemm g{(const bf16*)(ws + WS_ACAT), (const bf16*)(ws + WS_TBT), 64 * GPAD, 64 * 256, 512, 512}; pg8::GroupOrder S{F.G, bx};
        pg8::EpiY E{H};
        pg8::gemm_phase<pg8::EpiY, pg8::GroupOrder, true, true>(F.lds, g, S, E); if (rep_ == PH_REPS(5) - 1) SEAM(5); }
    if (IN(6)) for (int rep_ = 0; rep_ < PH_REPS(6); ++rep_) { PH_PTRS();
        pg8::Gemm g{H, (const bf16*)(ws + WS_W_GLU), NTOK, 2 * DM, DM, DM}; pg8::StaticOrder S; S.init(NTOK, 2 * DM, F.G, bx);
        pg8::EpiGate<0> E{(bf16*)(ws + WS_G), DM};
        pg8::gemm_phase<pg8::EpiGate<0>, pg8::StaticOrder, true, true>(F.lds, g, S, E); if (rep_ == PH_REPS(6) - 1) SEAM(6); }
    const int NCB = (F.G >= 128) ? 32 : 0;
    if (IN(7)) for (int rep_ = 0; rep_ < PH_REPS(7); ++rep_) { PH_PTRS();
        pg8::Gemm g{(const bf16*)(ws + WS_G), (const bf16*)(ws + WS_W_S5OUT), NLAT, DM, DM, DM}; pg8::StaticOrder S; S.init(NLAT, DM, F.G, bx);
        pg8::EpiRes<false, true> E{inp(0), inp(2), X, X + (size_t)NLAT * DM, mod + 2 * DM};
        pg8::gemm_phase<pg8::EpiRes<false, true>, pg8::StaticOrder, true, true>(F.lds, g, S, E); if (rep_ == PH_REPS(7) - 1) SEAM(7); }
    if (IN(8)) for (int rep_ = 0; rep_ < PH_REPS(8); ++rep_) { PH_PTRS();
        if (bx < NCB || NCB == 0) {
            pg8::Gemm g{(const bf16*)(ws + WS_G) + (size_t)NLAT * DM, (const bf16*)(ws + WS_W_S5OUT), NCTX, DM, DM, DM}; pg8::StaticOrder S; S.init(NCTX, DM, F.G, bx);
            pg8::EpiRes<false, true> E{inp(0), inp(2), X, X + (size_t)NLAT * DM, mod + 2 * DM, NLAT};
            pg8::gemm_phase<pg8::EpiRes<false, true>, pg8::StaticOrder, true, true>(F.lds, g, S, E); }
        if (bx >= NCB) modnorm_rows<true>(F, X, X + (size_t)NLAT * DM, NLAT, H, inp(7), mod, 3, 4, nullptr, nullptr, 0, NCB * NWAVES);
        xcd_barrier(xbar);
        modnorm_rows<true>(F, X, X + (size_t)NLAT * DM, NTOK, H, inp(7), mod, 3, 4, nullptr, nullptr, NLAT, 0);
        if (rep_ == PH_REPS(8) - 1) SEAM(8); }
    if (IN(9)) for (int rep_ = 0; rep_ < PH_REPS(9); ++rep_) { PH_PTRS();
        pg8::Gemm g{H, (const bf16*)(ws + WS_W_FFIN0), NTOK, 2 * FH, DM, DM}; pg8::StaticOrder S; S.init(NTOK, 2 * FH, F.G, bx);
        pg8::EpiGate<1> E{(bf16*)(ws + WS_A1), FH};
        pg8::gemm_phase<pg8::EpiGate<1>, pg8::StaticOrder, true, true>(F.lds, g, S, E); if (rep_ == PH_REPS(9) - 1) SEAM(9); }
    if (IN(10)) for (int rep_ = 0; rep_ < PH_REPS(10); ++rep_) { PH_PTRS();
        pg8::Gemm g{(const bf16*)(ws + WS_A1), (const bf16*)(ws + WS_W_FFOUT0), NLAT, DM, FH, FH}; pg8::StaticOrder S; S.init(NLAT, DM, F.G, bx);
        pg8::EpiRes<true, true> E{X, X, X, X, mod + 5 * DM};
        pg8::gemm_phase<pg8::EpiRes<true, true>, pg8::StaticOrder, true, true>(F.lds, g, S, E); if (rep_ == PH_REPS(10) - 1) SEAM(10); }
    if (IN(11)) for (int rep_ = 0; rep_ < PH_REPS(11); ++rep_) { PH_PTRS();
        if (bx < 2 * NCB || NCB == 0) {
#pragma unroll
            for (int sl = 0; sl < 2; ++sl) {
              pg8::Gemm g{(const bf16*)(ws + WS_A1) + (size_t)NLAT * FH + sl * (FH / 2), (const bf16*)(ws + WS_W_FFOUT0) + sl * (FH / 2), NCTX, DM, FH / 2, FH, FH};
              pg8::StaticOrder S; S.init(NCTX, DM, F.G, (bx + F.G - 32 * sl) % F.G);
              pg8::EpiPart E{(float*)(ws + WS_PPART) + (size_t)sl * NCTX * DM};
              pg8::gemm_phase<pg8::EpiPart, pg8::StaticOrder, true, true>(F.lds, g, S, E); } }
        if (bx >= 2 * NCB) modnorm_rows<true>(F, X, X + (size_t)NLAT * DM, NLAT, H, inp(6) + DM, mod1, 0, 1, nullptr, nullptr, 0, 2 * NCB * NWAVES);
        xcd_barrier(xbar);
        modnorm_rows<true>(F, X, X + (size_t)NLAT * DM, NTOK, H, inp(6) + DM, mod1, 0, 1, (const float*)(ws + WS_PPART), mod + 8 * MODS + 5 * DM, NLAT, 0);
        if (rep_ == PH_REPS(11) - 1) SEAM(11); }
    if (IN(12)) for (int rep_ = 0; rep_ < PH_REPS(12); ++rep_) { PH_PTRS();
        pg8::Gemm g{H, (const bf16*)(ws + WS_W_MLAIN), NTOK, DM, DM, DM}; pg8::StaticOrder S; S.init(NTOK, DM, F.G, bx);
        pg8::EpiPlain E{(bf16*)(ws + WS_PX), DM};
        pg8::gemm_phase<pg8::EpiPlain, pg8::StaticOrder, true, true>(F.lds, g, S, E); if (rep_ == PH_REPS(12) - 1) SEAM(12); }
    if (IN(13)) for (int rep_ = 0; rep_ < PH_REPS(13); ++rep_) { PH_PTRS(); p12_lrnorm(F, args); if (rep_ == PH_REPS(13) - 1) SEAM(13); }
    if (IN(14)) for (int rep_ = 0; rep_ < PH_REPS(14); ++rep_) { PH_PTRS();
        { pg8::Gemm g{(const bf16*)((unsigned char*)F.out + OUT_QL), (const bf16*)(ws + WS_W_QB), NLAT, NHEAD * QKD, QLR, QLR}; pg8::StaticOrder S; S.init(NLAT, NHEAD * QKD, F.G, bx);
          pg8::EpiPlain E{(bf16*)F.out, NHEAD * QKD};
          pg8::gemm_phase<pg8::EpiPlain, pg8::StaticOrder, true, true>(F.lds, g, S, E); }
        { pg8::Gemm g{(const bf16*)(ws + WS_CKV), (const bf16*)(ws + WS_W_KVB), NTOK, 2048, KVLR, KVLR}; pg8::StaticOrder S; S.init(NTOK, 2048, F.G, bx);
          pg8::EpiKV E{(bf16*)(ws + WS_KH), (bf16*)(ws + WS_VH), (const bf16*)(ws + WS_KPE), inp(27)};
          pg8::gemm_phase<pg8::EpiKV, pg8::StaticOrder, true, true>(F.lds, g, S, E); }
        if (rep_ == PH_REPS(14) - 1) SEAM(14); }
    if (IN(16)) for (int rep_ = 0; rep_ < PH_REPS(16); ++rep_) { PH_PTRS();
        const int vcu = (F.G % 8 == 0) ? (bx % 8) * (F.G / 8) + bx / 8 : bx;
        float negB;
        { const float* gq = inp(26); const float* gk = inp(27); const int l = tid_() & 63; float a = fabsf(gq[l]), c = fabsf(gk[l]);
          if (l < 32) { a = fmaxf(a, fabsf(gq[64 + l])); c = fmaxf(c, fabsf(gk[64 + l])); }
#pragma unroll
          for (int o = 1; o < 64; o <<= 1) { a = fmaxf(a, __shfl_xor(a, o)); c = fmaxf(c, __shfl_xor(c, o)); }
          negB = -(96.0f * 0.10206207261596575f * 1.4426950408889634f * 1.01f) * a * c;
          negB = __uint_as_float(__builtin_amdgcn_readfirstlane(__float_as_uint(negB))); }
#if defined(PROBE_ATT2)
        for (int rep = 0; rep < 2; ++rep)
#endif
        for (int u = vcu; u < NBATCH * NHEAD * (SEQ / 256); u += F.G) {
            const int bh = u >> 4, qb = u & 15, b = bh >> 4, h = bh & 15;
            if (negB < -100.0f) att::attn_dense_body<true>((const bf16*)F.out + ((size_t)(b * SEQ + qb * 256)) * (NHEAD * QKD) + h * QKD,
                                 (const bf16*)(ws + WS_KH) + (size_t)bh * SPB * 128, (const bf16*)(ws + WS_VH) + (size_t)bh * SPB * VD,
                                 H + ((size_t)(b * SEQ + qb * 256)) * DM + h * VD, SPB, (char*)lds, F.lds, negB, inp(26), qb * 256);
            else att::attn_dense_body<false>((const bf16*)F.out + ((size_t)(b * SEQ + qb * 256)) * (NHEAD * QKD) + h * QKD,
                                 (const bf16*)(ws + WS_KH) + (size_t)bh * SPB * 128, (const bf16*)(ws + WS_VH) + (size_t)bh * SPB * VD,
                                 H + ((size_t)(b * SEQ + qb * 256)) * DM + h * VD, SPB, (char*)lds, F.lds, negB, inp(26), qb * 256);
        }
        if (rep_ == PH_REPS(16) - 1) SEAM(16); }
    if (IN(17)) for (int rep_ = 0; rep_ < PH_REPS(17); ++rep_) { PH_PTRS();
        pg8::Gemm g{H, (const bf16*)(ws + WS_W_O), NLAT, DM, DM, DM}; pg8::StaticOrder S; S.init(NLAT, DM, F.G, bx);
        bf16* X3 = X + (size_t)NTOK * DM;
        pg8::EpiRes<true, true> E{X, X, X3, X3, mod1 + 2 * DM};
        pg8::gemm_phase<pg8::EpiRes<true, true>, pg8::StaticOrder, true, true>(F.lds, g, S, E); if (rep_ == PH_REPS(17) - 1) SEAM(17); }
    if (IN(18)) for (int rep_ = 0; rep_ < PH_REPS(18); ++rep_) { PH_PTRS(); modnorm_rows<true>(F, X + (size_t)NTOK * DM, X + (size_t)NTOK * DM, NLAT, H, inp(7) + DM, mod1, 3, 4); if (rep_ == PH_REPS(18) - 1) SEAM(18); }
    if (IN(19)) for (int rep_ = 0; rep_ < PH_REPS(19); ++rep_) { PH_PTRS();
        pg8::Gemm g{H, (const bf16*)(ws + WS_W_FFIN1), NLAT, 2 * FH, DM, DM}; pg8::StaticOrder S; S.init(NLAT, 2 * FH, F.G, bx);
        pg8::EpiGate<1> E{(bf16*)(ws + WS_A2), FH};
        pg8::gemm_phase<pg8::EpiGate<1>, pg8::StaticOrder, true, true>(F.lds, g, S, E); if (rep_ == PH_REPS(19) - 1) SEAM(19); }
    if (IN(20)) for (int rep_ = 0; rep_ < PH_REPS(20); ++rep_) { PH_PTRS();
        pg8::Gemm g{(const bf16*)(ws + WS_A2), (const bf16*)(ws + WS_W_FFOUT1), NLAT, DM, FH, FH}; pg8::StaticOrder S; S.init(NLAT, DM, F.G, bx);
        bf16* X3 = X + (size_t)NTOK * DM;
        pg8::EpiRes<true, false> E{X3, X3, F.out, F.out, mod1 + 5 * DM};
        pg8::gemm_phase<pg8::EpiRes<true, false>, pg8::StaticOrder, true, true>(F.lds, g, S, E); }
#undef IN
#undef SEAM
}

extern "C" void kernel_launch(void* const* d_in, const int* in_sizes, int n_in, void* d_out, int out_size, void* d_ws, size_t ws_size, hipStream_t stream) {
    static int grid = 0;
    if (grid == 0) {
        if (n_in != 29 || in_sizes[0] != NLAT * DM || out_size != NLAT * DM || ws_size < WS_END) {
            fprintf(stderr, "kernel_launch: unexpected shapes: n_in %d in0 %d out %d ws %zu (need >= %zu); nothing launched\n", n_in, n_in > 0 ? in_sizes[0] : -1, out_size, ws_size, (size_t)WS_END); grid = -1; return; }
        int dev = 0, cus = 0, per_cu = 0;
        if (hipGetDevice(&dev) != hipSuccess || hipDeviceGetAttribute(&cus, hipDeviceAttributeMultiprocessorCount, dev) != hipSuccess) { fprintf(stderr, "kernel_launch: device query failed\n"); grid = -1; return; }
        if (hipFuncSetAttribute((const void*)mk_fwd, hipFuncAttributeMaxDynamicSharedMemorySize, LDS_BYTES) != hipSuccess) { fprintf(stderr, "kernel_launch: hipFuncSetAttribute failed\n"); grid = -1; return; }
        if (hipOccupancyMaxActiveBlocksPerMultiprocessor(&per_cu, (const void*)mk_fwd, NWAVES * 64, LDS_BYTES) != hipSuccess || per_cu < 1) { fprintf(stderr, "kernel_launch: occupancy query failed (%d)\n", per_cu); (void)hipGetLastError(); per_cu = 1; }
        grid = cus * 1;
        fprintf(stderr, "kernel_launch: cus %d per_cu %d grid %d\n", cus, per_cu, grid);
    }
    if (grid < 0) return;
    if (hipMemsetAsync((char*)d_ws + WS_CTL, 0, CTL_ZERO_BYTES, stream) != hipSuccess) { fprintf(stderr, "kernel_launch: memset failed\n"); return; }
    Args a{};
    for (int i = 0; i < 29; ++i) a.in[i] = (const float*)d_in[i];
    a.out = (float*)d_out; a.ws = (unsigned char*)d_ws;
#if MK_MULTI
    for (int p = 0; p < NPHASE; ++p) { a.ph_lo = p; a.ph_hi = p + 1; hipLaunchKernelGGL(mk_fwd, dim3(grid), dim3(NWAVES * 64), LDS_BYTES, stream, a); }
#else
    a.ph_lo = 0; a.ph_hi = NPHASE;
    void* kargs[] = {&a};
    hipError_t e = hipLaunchCooperativeKernel((const void*)mk_fwd, dim3(grid), dim3(NWAVES * 64), kargs, LDS_BYTES, stream);
    if (e != hipSuccess) fprintf(stderr, "kernel_launch: cooperative launch failed: %s (grid %d)\n", hipGetErrorString(e), grid);
#endif
    const hipError_t le = hipPeekAtLastError();
    if (le != hipSuccess) fprintf(stderr, "kernel_launch: launch failed: %s\n", hipGetErrorName(le));
}
```

```cpp
#include <hip/hip_runtime.h>
#include <hip/hip_cooperative_groups.h>
#include <cstdio>
#include <cstdint>
namespace cg = cooperative_groups;

#ifndef MK_MULTI
#define MK_MULTI 0
#endif

constexpr int DM = 1024, NBATCH = 8, SEQ = 4096, CTXL = 256;
constexpr int NLAT = NBATCH * SEQ, NCTX = NBATCH * CTXL, NTOK = NLAT + NCTX;
constexpr int FH = 2816;
constexpr int SPB = CTXL + SEQ;
constexpr int NCH = SPB / 16;
constexpr int GROWS = NBATCH * NCH;
constexpr int GPAD = 2304;
constexpr int NHEAD = 16, QKD = 96, VD = 64, QLR = 512, KVLR = 256;
constexpr float EPS = 1e-6f;
constexpr int MODS = 6 * DM;

constexpr size_t MiB = 1u << 20;
constexpr size_t WS_CTL = 0, CTL_ZERO_BYTES = 1 * MiB;
constexpr size_t WS_MOD = 4096;
constexpr size_t WS_BAR = 512 * 1024;
constexpr size_t WS_APOW = 1 * MiB;
constexpr size_t WS_BBAR = 3 * MiB;
constexpr size_t WS_KC = 4 * MiB;
constexpr size_t WS_KPE = 6 * MiB;
constexpr size_t WS_WBT = 9 * MiB;
constexpr size_t WS_TBT = 17 * MiB;
constexpr size_t WS_W_S5IN = 33 * MiB, WS_W_GLU = 35 * MiB, WS_W_S5OUT = 39 * MiB, WS_W_FFIN0 = 41 * MiB, WS_W_FFIN1 = 52 * MiB;
constexpr size_t WS_W_FFOUT0 = 63 * MiB, WS_W_FFOUT1 = 69 * MiB, WS_W_MLAIN = 75 * MiB, WS_W_QB = 77 * MiB, WS_W_KVB = 79 * MiB, WS_W_O = 80 * MiB;
constexpr size_t WS_X = 96 * MiB;
constexpr size_t WS_H = 232 * MiB;
constexpr size_t WS_BIG = 300 * MiB;
constexpr size_t WS_ACAT = WS_BIG;
constexpr size_t WS_G = WS_BIG, WS_A1 = WS_BIG, WS_PX = WS_BIG, WS_CKV = 9 * MiB  , WS_KH = WS_BIG, WS_VH = 444 * MiB, WS_A2 = WS_BIG;
constexpr size_t WS_PPART = 488 * MiB;
constexpr size_t OUT_QL = 96 * MiB;
constexpr size_t WS_END = 512 * MiB;

constexpr int LDS_BYTES = 147456;
constexpr int NWAVES = 8;

#define LAS __attribute__((address_space(3)))
typedef unsigned short bf16;
typedef float f32x2 __attribute__((ext_vector_type(2)));
typedef unsigned u32x2 __attribute__((ext_vector_type(2)));
#define LDS_WAIT() asm volatile("s_waitcnt lgkmcnt(0)" ::: "memory")

namespace pg8 {
#define PG8_LAS __attribute__((address_space(3)))
typedef unsigned short bf16_t;
typedef short bf16x8 __attribute__((ext_vector_type(8)));
typedef float f32x4 __attribute__((ext_vector_type(4)));
typedef unsigned u32x4 __attribute__((ext_vector_type(4)));
constexpr int BM = 256, BK = 64, HALF = 128, HTB = HALF * BK * 2  , STAGE_BYTES = 8 * HTB, NXCD = 8, WGM = 8;

__host__ __device__ __forceinline__ int lds_byte(int r, int c) { const int st = (r >> 4) * 2 + (c >> 5), rr = r & 15, cc = c & 31, ob = rr * 64 + cc * 2; return st * 1024 + (ob ^ (((ob >> 9) & 1) << 5)); }
__host__ __device__ __forceinline__ void stage_rc(int b, int& R, int& C) { const int st = b / 1024, sb = b % 1024, swz = sb ^ (((sb >> 9) & 1) << 5); R = (st >> 1) * 16 + swz / 64; C = (st & 1) * 32 + (swz % 64) / 2; }
__host__ __device__ __forceinline__ int perm32(int rho) { const int n = rho >> 4, i = rho & 15; return 8 * (i >> 2) + 4 * n + (i & 3); }

struct Unit { int pm, pn; };
struct Gemm { const bf16_t* A; const bf16_t* Bt; int M, N, K, lda; int ldb = 0; };

struct StaticOrder {
    int nM, nN, nwg, G, c;
    __host__ __device__ void init(int M, int N, int G_, int c_) { nM = M / BM; nN = N / BM; nwg = nM * nN; G = G_; c = c_; }
    __host__ __device__ bool next(int i, Unit& u) const {
        const long L = (long)i * G + c; if (L >= nwg) return false;
        int wgid = (int)L; { const int q = nwg / NXCD, r = nwg % NXCD, xcd = wgid % NXCD, off = wgid / NXCD; wgid = (xcd < r ? xcd * (q + 1) : r * (q + 1) + (xcd - r) * q) + off; }
        const int nig = WGM * nN, gid = wgid / nig, fm = gid * WGM, gsz = (nM - fm) < WGM ? (nM - fm) : WGM;
        u.pm = fm + ((wgid % nig) % gsz); u.pn = (wgid % nig) / gsz; return true;
    }
    __device__ __forceinline__ void a_ready(const Unit&) const {}
    __device__ __forceinline__ void done(const Unit&) const {}
};

__device__ __forceinline__ unsigned cvt_pk_bf16(float lo, float hi) { unsigned r; asm volatile("v_cvt_pk_bf16_f32 %0, %1, %2" : "=v"(r) : "v"(lo), "v"(hi)); return r; }

__device__ __forceinline__ u32x4 pack8(f32x4 v0, f32x4 v1) { u32x4 w; w.x = cvt_pk_bf16(v0[0], v0[1]); w.y = cvt_pk_bf16(v0[2], v0[3]); w.z = cvt_pk_bf16(v1[0], v1[1]); w.w = cvt_pk_bf16(v1[2], v1[3]); return w; }
__device__ __forceinline__ float sigmoidf_(float x) { return __builtin_amdgcn_rcpf(1.0f + __expf(-x)); }

struct EpiPlain {
    static constexpr bool PERM = true, AFTER_DRAIN = false;
    bf16_t* O; int ldc;
    __device__ __forceinline__ void operator()(const f32x4 (&acc)[2][2][4][2], const Unit& u, int wr, int wc, int fr, int fq) const {
        const int row0 = u.pm * BM + wr * 64 + fr, col0 = u.pn * BM + wc * 32 + 8 * fq;
#pragma unroll
        for (int ai = 0; ai < 2; ++ai)
#pragma unroll
            for (int m = 0; m < 4; ++m) { bf16_t* rowp = O + (size_t)(row0 + ai * HALF + m * 16) * ldc + col0;
#pragma unroll
                for (int bj = 0; bj < 2; ++bj) *(u32x4*)(rowp + bj * HALF) = pack8(acc[ai][bj][m][0], acc[ai][bj][m][1]); }
    }
};
template <int ACT> struct EpiGate {
    static constexpr bool PERM = true, AFTER_DRAIN = false;
    bf16_t* O; int ldc;
    __device__ __forceinline__ void operator()(const f32x4 (&acc)[2][2][4][2], const Unit& u, int wr, int wc, int fr, int fq) const {
        const int row0 = u.pm * BM + wr * 64 + fr, col0 = u.pn * HALF + wc * 32 + 8 * fq;
#pragma unroll
        for (int ai = 0; ai < 2; ++ai)
#pragma unroll
            for (int m = 0; m < 4; ++m) {
                f32x4 o[2];
#pragma unroll
                for (int n = 0; n < 2; ++n)
#pragma unroll
                    for (int i = 0; i < 4; ++i) { const float a = acc[ai][0][m][n][i], b = acc[ai][1][m][n][i];
                        o[n][i] = (ACT == 0) ? a * sigmoidf_(b) : a * sigmoidf_(a) * b; }
                *(u32x4*)(O + (size_t)(row0 + ai * HALF + m * 16) * ldc + col0) = pack8(o[0], o[1]); }
    }
};
template <bool BB, bool OB> struct EpiRes {
    static constexpr bool PERM = false, AFTER_DRAIN = false;
    const void* base_lat; const void* base_ctx; void* out_lat; void* out_ctx; const float* gate;
    int row_off = 0;
    __device__ __forceinline__ void operator()(const f32x4 (&acc)[2][2][4][2], const Unit& u, int wr, int wc, int fr, int fq) const {
        int row0 = u.pm * BM + wr * 64 + fr + row_off; const bool isctx = row0 >= NLAT; const int b = isctx ? 8 : (row0 >> 12);
        const void* bp = isctx ? base_ctx : base_lat; void* op = isctx ? out_ctx : out_lat; if (isctx) row0 -= NLAT;
        const int col0 = u.pn * BM + wc * 32 + 4 * fq;
        f32x4 gv[2][2];
#pragma unroll
        for (int bj = 0; bj < 2; ++bj)
#pragma unroll
            for (int n = 0; n < 2; ++n) gv[bj][n] = *(const f32x4*)(gate + b * MODS + col0 + bj * HALF + n * 16);
#pragma unroll
        for (int ai = 0; ai < 2; ++ai)
#pragma unroll
            for (int m = 0; m < 4; ++m) { const size_t off = (size_t)(row0 + ai * HALF + m * 16) * DM + col0;
#pragma unroll
                for (int bj = 0; bj < 2; ++bj)
#pragma unroll
                    for (int n = 0; n < 2; ++n) { const size_t o2 = off + bj * HALF + n * 16; f32x4 bs;
                        if (BB) { const u32x2 r = *(const u32x2*)((const bf16_t*)bp + o2); bs = (f32x4){__uint_as_float(r.x << 16), __uint_as_float(r.x & 0xffff0000u), __uint_as_float(r.y << 16), __uint_as_float(r.y & 0xffff0000u)}; }
                        else bs = *(const f32x4*)((const float*)bp + o2);
                        const f32x4 o = bs + gv[bj][n] * acc[ai][bj][m][n];
                        if (OB) { u32x2 w; w.x = cvt_pk_bf16(o[0], o[1]); w.y = cvt_pk_bf16(o[2], o[3]); *(u32x2*)((bf16_t*)op + o2) = w; }
                        else *(f32x4*)((float*)op + o2) = o; } }
    }
};
struct EpiPart {
    static constexpr bool PERM = false, AFTER_DRAIN = false;
    float* P;
    __device__ __forceinline__ void operator()(const f32x4 (&acc)[2][2][4][2], const Unit& u, int wr, int wc, int fr, int fq) const {
        float* base = P + (size_t)(u.pm * BM + wr * 64 + fr) * DM + u.pn * BM + wc * 32 + 4 * fq;
#pragma unroll
        for (int ai = 0; ai < 2; ++ai)
#pragma unroll
            for (int m = 0; m < 4; ++m)
#pragma unroll
                for (int bj = 0; bj < 2; ++bj)
#pragma unroll
                    for (int n = 0; n < 2; ++n) *(f32x4*)(base + (size_t)(ai * HALF + m * 16) * DM + bj * HALF + n * 16) = acc[ai][bj][m][n];
    }
};
__device__ __forceinline__ void row_to_bsp(int row, int& b, int& sp) { if (row < NLAT) { b = row >> 12; sp = CTXL + (row & (SEQ - 1)); } else { const int rr = row - NLAT; b = rr >> 8; sp = rr & (CTXL - 1); } }
__device__ __forceinline__ int bsp_to_row(int b, int sp) { return sp < CTXL ? NLAT + b * CTXL + sp : b * SEQ + sp - CTXL; }
struct EpiU {
    static constexpr bool PERM = true, AFTER_DRAIN = false;
    bf16_t* ACAT; int pm_off = 0;
    __device__ __forceinline__ void operator()(const f32x4 (&acc)[2][2][4][2], const Unit& u, int wr, int wc, int fr, int fq) const {
        const int pmm = u.pm + pm_off;
        const int b = pmm < 128 ? (pmm >> 4) : (pmm - 128), sp0 = (pmm < 128 ? CTXL + (pmm & 15) * 256 : 0) + wr * 64 + fr;
        const int col0 = u.pn * BM + wc * 32 + 8 * fq, g0 = col0 >> 4, c0 = col0 & 15;
        bf16_t* base = ACAT + ((size_t)(g0 * GPAD + b * NCH) * 512 + c0);
#pragma unroll
        for (int ai = 0; ai < 2; ++ai)
#pragma unroll
            for (int m = 0; m < 4; ++m) { const int sp = sp0 + ai * HALF + m * 16; bf16_t* rp = base + (size_t)(sp >> 4) * 512 + (sp & 15) * 16;
#pragma unroll
                for (int bj = 0; bj < 2; ++bj) *(u32x4*)(rp + (size_t)bj * 8 * GPAD * 512) = pack8(acc[ai][bj][m][0], acc[ai][bj][m][1]); }
    }
};
struct EpiE {
    static constexpr bool PERM = false, AFTER_DRAIN = false;
    float* E;
    __device__ __forceinline__ void operator()(const f32x4 (&acc)[2][2][4][2], const Unit& u, int wr, int wc, int fr, int fq) const {
        const int g = u.pn, it = u.pm - 9 * g, rl0 = it * BM + wr * 64 + fr, col0 = wc * 32 + 4 * fq;
        float* base = E + ((size_t)g * GROWS + rl0) * 256 + col0;
#pragma unroll
        for (int ai = 0; ai < 2; ++ai) { if (ai == 1 && it == 8) continue;
#pragma unroll
            for (int m = 0; m < 4; ++m) { float* rp = base + (size_t)(ai * HALF + m * 16) * 256;
#pragma unroll
                for (int bj = 0; bj < 2; ++bj)
#pragma unroll
                    for (int n = 0; n < 2; ++n) *(f32x4*)(rp + bj * HALF + n * 16) = acc[ai][bj][m][n]; } }
    }
};
struct EpiY {
    static constexpr bool PERM = true, AFTER_DRAIN = false;
    bf16_t* Y;
    __device__ __forceinline__ void operator()(const f32x4 (&acc)[2][2][4][2], const Unit& u, int wr, int wc, int fr, int fq) const {
        const int g = u.pn, it = u.pm - 9 * g, rl0 = it * BM + wr * 64 + fr, col0 = wc * 32 + 8 * fq, tau0 = col0 >> 4, c0 = col0 & 15;
#pragma unroll
        for (int ai = 0; ai < 2; ++ai) { if (ai == 1 && it == 8) continue;
#pragma unroll
            for (int m = 0; m < 4; ++m) { const int rl = rl0 + ai * HALF + m * 16; const int b = rl / NCH, ch = rl - b * NCH;
#pragma unroll
                for (int bj = 0; bj < 2; ++bj) { const int row = bsp_to_row(b, ch * 16 + tau0 + bj * 8);
                    f32x4 o[2];
#pragma unroll
                    for (int n = 0; n < 2; ++n)
#pragma unroll
                        for (int i = 0; i < 4; ++i) { const float y = acc[ai][bj][m][n][i]; const float z = 0.7978845608028654f * (y + 0.044715f * y * y * y); o[n][i] = y * sigmoidf_(2.0f * z); }
                    *(u32x4*)(Y + (size_t)row * DM + g * 16 + c0) = pack8(o[0], o[1]); } } }
    }
};
struct EpiKV {
    static constexpr bool PERM = true, AFTER_DRAIN = false;
    bf16_t* KH; bf16_t* VH; const bf16_t* KPE; const float* gk;
    __device__ __forceinline__ void operator()(const f32x4 (&acc)[2][2][4][2], const Unit& u, int wr, int wc, int fr, int fq) const {
        const bool lat = u.pm < 128;
        const int b = lat ? (u.pm >> 4) : (u.pm - 128), sp0 = (lat ? CTXL + (u.pm & 15) * 256 : 0) + wr * 64 + fr;
        const int row0 = u.pm * BM + wr * 64 + fr;
        if (u.pn < 4) {
            const int h = 4 * u.pn + wc;
            f32x4 g0[2], g1[2];
#pragma unroll
            for (int bj = 0; bj < 2; ++bj) { g0[bj] = *(const f32x4*)(gk + 32 * bj + 8 * fq); g1[bj] = *(const f32x4*)(gk + 32 * bj + 8 * fq + 4); }
            const f32x4 gp0 = *(const f32x4*)(gk + 64 + 8 * fq), gp1 = *(const f32x4*)(gk + 64 + 8 * fq + 4);
            const float invf[8] = {1.0f, 0.31622776601683794f, 0.1f, 0.031622776601683794f, 0.01f, 0.0031622776601683794f, 0.001f, 0.00031622776601683794f};
            const float sgn = (fq & 1) ? 1.0f : -1.0f;
#pragma unroll
            for (int ai = 0; ai < 2; ++ai)
#pragma unroll
                for (int m = 0; m < 4; ++m) { const int row = row0 + ai * HALF + m * 16, sp = sp0 + ai * HALF + m * 16;
                    const u32x4 praw = *(const u32x4*)(KPE + (size_t)row * 32 + 8 * fq); float pe[8];
#pragma unroll
                    for (int e = 0; e < 4; ++e) { pe[2 * e] = __uint_as_float(praw[e] << 16); pe[2 * e + 1] = __uint_as_float(praw[e] & 0xffff0000u); }
                    float ss = 0.f;
#pragma unroll
                    for (int bj = 0; bj < 2; ++bj)
#pragma unroll
                        for (int n = 0; n < 2; ++n) { const f32x4 v = acc[ai][bj][m][n]; ss += (v[0] * v[0] + v[1] * v[1]) + (v[2] * v[2] + v[3] * v[3]); }
#pragma unroll
                    for (int e = 0; e < 8; ++e) ss += pe[e] * pe[e];
                    ss += __shfl_xor(ss, 16); ss += __shfl_xor(ss, 32);
                    const float rstd = rsqrtf(ss * (1.0f / 96.0f) + EPS);
                    bf16_t* kd = KH + ((size_t)(b * NHEAD + h) * SPB + sp) * 128;
#pragma unroll
                    for (int bj = 0; bj < 2; ++bj) *(u32x4*)(kd + 32 * bj + 8 * fq) = pack8(acc[ai][bj][m][0] * rstd * g0[bj], acc[ai][bj][m][1] * rstd * g1[bj]);
                    const int l = sp - CTXL; const float pos = (fq >> 1) ? (float)(l & 63) : (float)(l >> 6);
                    f32x4 o0, o1;
#pragma unroll
                    for (int e = 0; e < 8; ++e) { const float own = pe[e] * rstd * (e < 4 ? gp0[e & 3] : gp1[e & 3]); const float other = __shfl_xor(own, 16);
                        float cs = 1.f, sn = 0.f; if (lat) { const float ang = pos * invf[e]; cs = __cosf(ang); sn = __sinf(ang); }
                        const float r = own * cs + sgn * other * sn; if (e < 4) o0[e & 3] = r; else o1[e & 3] = r; }
                    *(u32x4*)(kd + 64 + 8 * fq) = pack8(o0, o1);
                    if (fq < 2) *(u32x4*)(kd + 96 + 8 * fq) = (u32x4){fq == 0 ? 0x3F80u : 0u, 0u, 0u, 0u};
                }
        } else {
            const int hl = wc >> 1, vd0 = (32 * wc + 8 * fq) & 63;
            bf16_t* base = VH + ((size_t)(b * NHEAD + 4 * (u.pn - 4) + hl) * SPB + sp0) * VD + vd0;
#pragma unroll
            for (int ai = 0; ai < 2; ++ai)
#pragma unroll
                for (int m = 0; m < 4; ++m)
#pragma unroll
                    for (int bj = 0; bj < 2; ++bj) *(u32x4*)(base + (size_t)(ai * HALF + m * 16) * VD + (size_t)(2 * bj) * SPB * VD) = pack8(acc[ai][bj][m][0], acc[ai][bj][m][1]);
        }
    }
};
struct GroupOrder {
    int G, c;
    __device__ __forceinline__ bool next(int i, Unit& u) const { const long L = (long)i * G + c; if (L >= 64 * 9) return false; u.pm = (int)L; u.pn = (int)L / 9; return true; }
    __device__ __forceinline__ void a_ready(const Unit&) const {}
    __device__ __forceinline__ void done(const Unit&) const {}
};

template <class Epi, class Sched, bool ALIGN_EPI = false, bool SP2 = false>
__device__ __forceinline__ void gemm_phase(PG8_LAS unsigned char* lds, const Gemm g, const Sched& S, const Epi& E) {
    const int tid = threadIdx.x, wid = __builtin_amdgcn_readfirstlane(tid >> 6), lane = tid & 63, wr = wid >> 2, wc = wid & 3, fr = lane & 15, fq = lane >> 4;
    int K_ = g.K; asm volatile("" : "+s"(K_));
    const int K = K_, nt = K / BK, ldb = g.ldb ? g.ldb : K_;
    unsigned voffA[2], voffB[2];
#pragma unroll
    for (int i = 0; i < 2; ++i) { int R, C; stage_rc(tid * 16 + i * 8192, R, C); const int Rb = Epi::PERM ? ((R & ~31) + perm32(R & 31)) : R;
        voffA[i] = (unsigned)(R * g.lda + C) * 2u; voffB[i] = (unsigned)(Rb * ldb + C) * 2u; }
    const size_t kstep = (size_t)(BK * 2);
    const size_t hstep = (size_t)HALF * ldb * 2;
    const size_t tstep = 2 * hstep; const size_t hstepA = (size_t)HALF * g.lda * 2, tstepA = 2 * hstepA;
    const unsigned ldsw = (unsigned)wid * 1024u;
    const int aoff = lds_byte(wr * 64 + fr, fq * 8), boff = lds_byte(wc * 32 + fr, fq * 8);
#define PG8_SA(b, h) (((b) * 2 + (h)) * HTB)
#define PG8_SB(b, h) ((4 + (b) * 2 + (h)) * HTB)
#define PG8_STAGE(bufoff, gbase, voff) do { _Pragma("unroll") for (int _i = 0; _i < 2; ++_i) \
        __builtin_amdgcn_global_load_lds((const unsigned*)((const char*)(gbase) + (voff)[_i]), (PG8_LAS unsigned*)(lds + (bufoff) + ldsw + _i * 8192), 16, 0, 0); } while (0)
#define PG8_LDA(dst, b, h) do { _Pragma("unroll") for (int m = 0; m < 4; ++m) _Pragma("unroll") for (int k = 0; k < 2; ++k) dst[m][k] = *(const PG8_LAS bf16x8*)(lds + PG8_SA(b, h) + aoff + m * 2048 + k * 1024); } while (0)
#define PG8_LDB(dst, b, h) do { _Pragma("unroll") for (int n = 0; n < 2; ++n) _Pragma("unroll") for (int k = 0; k < 2; ++k) dst[n][k] = *(const PG8_LAS bf16x8*)(lds + PG8_SB(b, h) + boff + n * 2048 + k * 1024); } while (0)
#define PG8_MMA(ai, bj, At, Bt) do { __builtin_amdgcn_s_setprio(1); _Pragma("unroll") for (int m = 0; m < 4; ++m) _Pragma("unroll") for (int n = 0; n < 2; ++n) _Pragma("unroll") for (int k = 0; k < 2; ++k) \
        acc[ai][bj][m][n] = __builtin_amdgcn_mfma_f32_16x16x32_bf16(Bt[n][k], At[m][k], acc[ai][bj][m][n], 0, 0, 0); __builtin_amdgcn_s_setprio(0); } while (0)
#define PG8_WAIT_V(n) asm volatile("s_waitcnt vmcnt(" #n ")" ::: "memory")
#define PG8_WAIT_L(n) asm volatile("s_waitcnt lgkmcnt(" #n ")" ::: "memory")
#define PG8_BAR __builtin_amdgcn_s_barrier()
#define PG8_SCHED __builtin_amdgcn_sched_barrier(0)
    Unit cur, nxt; int ui = 0;
    if (!S.next(0, cur)) return;
    f32x4 acc[2][2][4][2];
#pragma unroll
    for (int a = 0; a < 2; ++a)
#pragma unroll
        for (int b = 0; b < 2; ++b)
#pragma unroll
            for (int m = 0; m < 4; ++m)
#pragma unroll
                for (int n = 0; n < 2; ++n) acc[a][b][m][n] = (f32x4){0.f, 0.f, 0.f, 0.f};
    bf16x8 At[4][2], B0[2][2], B1[2][2];
    const char* cA = (const char*)g.A + (size_t)cur.pm * tstepA; const char* cB = (const char*)g.Bt + (size_t)cur.pn * tstep;
    S.a_ready(cur);
    if constexpr (SP2) {
        PG8_STAGE(PG8_SB(0, 0), cB, voffB); PG8_STAGE(PG8_SB(0, 1), cB + hstep, voffB); PG8_STAGE(PG8_SA(0, 0), cA, voffA); PG8_STAGE(PG8_SA(0, 1), cA + hstepA, voffA);
        if (wr == 1) PG8_BAR;
        PG8_WAIT_V(2); PG8_BAR;
        PG8_STAGE(PG8_SB(1, 0), cB + kstep, voffB); PG8_STAGE(PG8_SA(1, 0), cA + kstep, voffA); PG8_STAGE(PG8_SB(1, 1), cB + hstep + kstep, voffB);
        PG8_WAIT_V(6); PG8_BAR;
    } else {
        PG8_STAGE(PG8_SB(0, 0), cB, voffB); PG8_STAGE(PG8_SA(0, 0), cA, voffA); PG8_STAGE(PG8_SB(0, 1), cB + hstep, voffB); PG8_STAGE(PG8_SA(0, 1), cA + hstepA, voffA);
        if (wr == 1) PG8_BAR;
        PG8_WAIT_V(4); PG8_BAR;
        PG8_STAGE(PG8_SB(1, 0), cB + kstep, voffB); PG8_STAGE(PG8_SA(1, 0), cA + kstep, voffA); PG8_STAGE(PG8_SB(1, 1), cB + hstep + kstep, voffB);
        PG8_WAIT_V(6); PG8_BAR;
    }
    for (;;) {
        const bool has_next = S.next(ui + 1, nxt);
        const char* nA = has_next ? (const char*)g.A + (size_t)nxt.pm * tstepA : cA; const char* nB = has_next ? (const char*)g.Bt + (size_t)nxt.pn * tstep : cB;
        for (int t = 0; t < nt; t += 2) {
            const bool last = (t == nt - 2);
            const char* a1 = cA + (size_t)(t + 1) * kstep;
            const char* a2 = last ? nA : cA + (size_t)(t + 2) * kstep; const char* b2 = last ? nB : cB + (size_t)(t + 2) * kstep;
            const char* a3 = a2 + kstep; const char* b3 = b2 + kstep;
            if (last && has_next) S.a_ready(nxt);
            if constexpr (SP2) {
            PG8_LDB(B0, 0, 0); PG8_LDB(B1, 0, 1); PG8_SCHED; PG8_LDA(At, 0, 0); PG8_STAGE(PG8_SA(1, 1), a1 + hstepA, voffA);
            PG8_WAIT_V(8); PG8_WAIT_L(0); PG8_BAR; PG8_MMA(0, 0, At, B0); PG8_MMA(0, 1, At, B1); PG8_BAR; PG8_SCHED;
            PG8_LDA(At, 0, 1); PG8_STAGE(PG8_SB(0, 0), b2, voffB); PG8_STAGE(PG8_SB(0, 1), b2 + hstep, voffB); PG8_STAGE(PG8_SA(0, 0), a2, voffA);
            PG8_WAIT_V(8); PG8_WAIT_L(0); PG8_BAR; PG8_MMA(1, 0, At, B0); PG8_MMA(1, 1, At, B1); PG8_BAR; PG8_SCHED;
            PG8_LDB(B0, 1, 0); PG8_LDB(B1, 1, 1); PG8_SCHED; PG8_LDA(At, 1, 0); PG8_STAGE(PG8_SA(0, 1), a2 + hstepA, voffA);
            PG8_WAIT_V(8); PG8_WAIT_L(0); PG8_BAR; PG8_MMA(0, 0, At, B0); PG8_MMA(0, 1, At, B1); PG8_BAR; PG8_SCHED;
            PG8_LDA(At, 1, 1); PG8_STAGE(PG8_SB(1, 0), b3, voffB); PG8_STAGE(PG8_SB(1, 1), b3 + hstep, voffB); PG8_STAGE(PG8_SA(1, 0), a3, voffA);
            PG8_WAIT_V(8); PG8_WAIT_L(0); PG8_BAR; PG8_MMA(1, 0, At, B0); PG8_MMA(1, 1, At, B1); PG8_BAR; PG8_SCHED;
            } else {
            PG8_LDB(B0, 0, 0); PG8_SCHED; PG8_LDA(At, 0, 0); PG8_STAGE(PG8_SA(1, 1), a1 + hstepA, voffA);
            PG8_WAIT_L(8); PG8_BAR; PG8_WAIT_L(0); PG8_MMA(0, 0, At, B0); PG8_BAR; PG8_SCHED;
            PG8_LDB(B1, 0, 1); PG8_STAGE(PG8_SB(0, 0), b2, voffB);
            PG8_BAR; PG8_WAIT_L(0); PG8_MMA(0, 1, At, B1); PG8_BAR;
            PG8_LDA(At, 0, 1); PG8_STAGE(PG8_SA(0, 0), a2, voffA);
            PG8_BAR; PG8_WAIT_L(0); PG8_MMA(1, 0, At, B0); PG8_BAR; PG8_SCHED;
            PG8_STAGE(PG8_SB(0, 1), b2 + hstep, voffB);
            PG8_WAIT_V(6); PG8_BAR; PG8_MMA(1, 1, At, B1); PG8_BAR;
            PG8_LDB(B0, 1, 0); PG8_SCHED; PG8_LDA(At, 1, 0); PG8_STAGE(PG8_SA(0, 1), a2 + hstepA, voffA);
            PG8_WAIT_L(8); PG8_BAR; PG8_WAIT_L(0); PG8_MMA(0, 0, At, B0); PG8_BAR; PG8_SCHED;
            PG8_LDB(B1, 1, 1); PG8_STAGE(PG8_SB(1, 0), b3, voffB);
            PG8_BAR; PG8_WAIT_L(0); PG8_MMA(0, 1, At, B1); PG8_BAR;
            PG8_LDA(At, 1, 1); PG8_STAGE(PG8_SA(1, 0), a3, voffA);
            PG8_BAR; PG8_WAIT_L(0); PG8_MMA(1, 0, At, B0); PG8_BAR; PG8_SCHED;
            PG8_STAGE(PG8_SB(1, 1), b3 + hstep, voffB);
            PG8_WAIT_V(6); PG8_BAR; PG8_MMA(1, 1, At, B1); PG8_BAR;
            }
        }
        if constexpr (ALIGN_EPI) { if (wr == 0) PG8_BAR; }
        if constexpr (!Epi::AFTER_DRAIN) { E(acc, cur, wr, wc, fr, fq); S.done(cur); }
        if (!has_next) break;
#pragma unroll
        for (int a = 0; a < 2; ++a)
#pragma unroll
            for (int b = 0; b < 2; ++b)
#pragma unroll
                for (int m = 0; m < 4; ++m)
#pragma unroll
                    for (int n = 0; n < 2; ++n) acc[a][b][m][n] = (f32x4){0.f, 0.f, 0.f, 0.f};
        cur = nxt; cA = nA; cB = nB; ++ui;
        if constexpr (ALIGN_EPI) { if (wr == 1) PG8_BAR; }
    }
    PG8_WAIT_V(0);
    if constexpr (!ALIGN_EPI) { if (wr == 0) PG8_BAR; }
    PG8_BAR;
    if constexpr (Epi::AFTER_DRAIN) { E.fused(acc, cur, wr, wc, fr, fq, lds, wid, lane); S.done(cur); }
#undef PG8_SA
#undef PG8_SB
#undef PG8_STAGE
#undef PG8_LDA
#undef PG8_LDB
#undef PG8_MMA
#undef PG8_WAIT_V
#undef PG8_WAIT_L
#undef PG8_BAR
#undef PG8_SCHED
}
}

using pg8::bf16x8; using pg8::f32x4; using pg8::u32x4; using pg8::cvt_pk_bf16;

struct Frame {
    LAS unsigned char* lds; int wave, G, gw, NGW, NGT;
    float* out; unsigned char* ws;
};
struct Args { const float* in[29]; float* out; unsigned char* ws; int ph_lo, ph_hi; };
typedef const float* cfptr;
#define CAS __attribute__((address_space(4)))
__device__ __forceinline__ const float* inp(int k) { const CAS cfptr* p = (const CAS cfptr*)__builtin_amdgcn_kernarg_segment_ptr(); asm volatile("" : "+s"(p)); return p[k]; }
__device__ __forceinline__ int tid_() { int t = threadIdx.x; asm volatile("" : "+v"(t)); return t; }
#define LANE_IDS() const int f_tid = tid_(); const int f_lane = f_tid & 63; const int f_gtid = blockIdx.x * (NWAVES * 64) + f_tid; (void)f_lane; (void)f_gtid
__device__ __forceinline__ float wave_sum(float v) {
#pragma unroll
    for (int o = 1; o < 64; o <<= 1) v += __shfl_xor(v, o);
    return v;
}
__device__ __forceinline__ float bf2f(unsigned short h) { return __uint_as_float(((unsigned)h) << 16); }
__device__ __forceinline__ void unpack8(const bf16x8 v, float* f) {
#pragma unroll
    for (int i = 0; i < 8; ++i) f[i] = bf2f((unsigned short)v[i]);
}
__device__ __forceinline__ u32x4 pack8f(const float* f) { u32x4 w; w.x = cvt_pk_bf16(f[0], f[1]); w.y = cvt_pk_bf16(f[2], f[3]); w.z = cvt_pk_bf16(f[4], f[5]); w.w = cvt_pk_bf16(f[6], f[7]); return w; }

__device__ __forceinline__ void transpose_item(const float* W, int K, int N, bf16* WT, int mode, int Hh, LAS float* scr, int item, int lane) {
    const int nblk = N / 32, kb = item / nblk, nb = item % nblk, k0 = 64 * kb, n0 = 32 * nb;
#pragma unroll 8
    for (int i = 0; i < 32; ++i) { const int kk = 2 * i + (lane >> 5); scr[kk * 33 + (lane & 31)] = W[(size_t)(k0 + kk) * N + n0 + (lane & 31)]; }
    LDS_WAIT(); asm volatile("" ::: "memory");
    int rbase = n0;
    if (mode == 1) { if (n0 < Hh) rbase = (n0 >> 7) * 256 + (n0 & 127); else { const int mm = n0 - Hh; rbase = (mm >> 7) * 256 + 128 + (mm & 127); } }
    if (mode == 2) { const int head = n0 >> 7, o = n0 & 127; rbase = (o < 64) ? 256 * (head >> 2) + 128 * (o >> 5) + 32 * (head & 3) : 1024 + 256 * (head >> 2) + 64 * (head & 3) + (o - 64); }
    const int c = lane & 7;
#pragma unroll
    for (int j = 0; j < 4; ++j) { const int n = (lane >> 3) + 8 * j; const LAS float* s = scr + (8 * c) * 33 + n;
        u32x4 o; o.x = cvt_pk_bf16(s[0 * 33], s[1 * 33]); o.y = cvt_pk_bf16(s[2 * 33], s[3 * 33]); o.z = cvt_pk_bf16(s[4 * 33], s[5 * 33]); o.w = cvt_pk_bf16(s[6 * 33], s[7 * 33]);
        *(u32x4*)(WT + (size_t)(rbase + n) * K + k0 + 8 * c) = o; }
    LDS_WAIT(); asm volatile("" ::: "memory");
}
__device__ __forceinline__ void p0a(Frame& F, const Args& A) {
    LANE_IDS();
    LAS float* scr = (LAS float*)(F.lds + F.wave * 16384);
    unsigned char* ws = F.ws;
    constexpr int I_SQ = 16 * 32, I_GLU = 16 * 64, I_FFIN = 16 * 176, I_FFOUT = 44 * 32, I_MLAIN = 16 * 25, I_QB = 8 * 48, I_KVB = 4 * 64;
    constexpr int NITEMS = 3 * I_SQ + I_GLU + 2 * I_FFIN + 2 * I_FFOUT + I_MLAIN + I_QB + I_KVB;
    for (int it = F.gw; it < NITEMS; it += F.NGW) {
        int r = it;
        if (r < I_FFIN) { transpose_item(inp(8), DM, 2 * FH, (bf16*)(ws + WS_W_FFIN0), 1, FH, scr, r, f_lane); continue; } r -= I_FFIN;
        if (r < I_FFIN) { transpose_item(inp(8) + (size_t)DM * 2 * FH, DM, 2 * FH, (bf16*)(ws + WS_W_FFIN1), 1, FH, scr, r, f_lane); continue; } r -= I_FFIN;
        if (r < I_FFOUT) { transpose_item(inp(9), FH, DM, (bf16*)(ws + WS_W_FFOUT0), 0, 0, scr, r, f_lane); continue; } r -= I_FFOUT;
        if (r < I_FFOUT) { transpose_item(inp(9) + (size_t)FH * DM, FH, DM, (bf16*)(ws + WS_W_FFOUT1), 0, 0, scr, r, f_lane); continue; } r -= I_FFOUT;
        if (r < I_GLU) { transpose_item(inp(19), DM, 2 * DM, (bf16*)(ws + WS_W_GLU), 1, DM, scr, r, f_lane); continue; } r -= I_GLU;
        if (r < I_SQ) { transpose_item(inp(10), DM, DM, (bf16*)(ws + WS_W_S5IN), 0, 0, scr, r, f_lane); continue; } r -= I_SQ;
        if (r < I_SQ) { transpose_item(inp(20), DM, DM, (bf16*)(ws + WS_W_S5OUT), 0, 0, scr, r, f_lane); continue; } r -= I_SQ;
        if (r < I_SQ) { transpose_item(inp(28), DM, DM, (bf16*)(ws + WS_W_O), 0, 0, scr, r, f_lane); continue; } r -= I_SQ;
        if (r < I_MLAIN) { transpose_item(inp(21), DM, 800, (bf16*)(ws + WS_W_MLAIN), 0, 0, scr, r, f_lane); continue; } r -= I_MLAIN;
        if (r < I_QB) { transpose_item(inp(24), QLR, NHEAD * QKD, (bf16*)(ws + WS_W_QB), 0, 0, scr, r, f_lane); continue; } r -= I_QB;
        transpose_item(inp(25), KVLR, 2048, (bf16*)(ws + WS_W_KVB), 2, 0, scr, r, f_lane);
    }
    { u32x4* z = (u32x4*)(ws + WS_W_MLAIN + (size_t)800 * DM * 2); const int nz = 224 * DM * 2 / 16;
      for (int i = f_gtid; i < nz; i += F.NGT) z[i] = (u32x4){0u, 0u, 0u, 0u}; }
    float* mod = (float*)(ws + WS_MOD);
    for (int unit = F.gw; unit < 2 * 96 * 8; unit += F.NGW) {
        const int l = unit / 768, r2 = unit % 768, cb = r2 >> 3, ks = r2 & 7, k0 = ks * 128, n = cb * 64 + f_lane;
#pragma unroll
        for (int r = 0; r < 9; ++r)
#pragma unroll
            for (int h = 0; h < 2; ++h) { const int k = k0 + h * 64 + f_lane; const float v = (r < 8) ? inp(1)[r * DM + k] : inp(3)[k]; scr[r * 128 + h * 64 + f_lane] = v * __builtin_amdgcn_rcpf(1.0f + __expf(-v)); }
        LDS_WAIT(); asm volatile("" ::: "memory");
        float acc[9];
        const float bias = (ks == 0) ? inp(5)[l * MODS + n] : 0.f;
#pragma unroll
        for (int r = 0; r < 9; ++r) acc[r] = bias;
        const float* W = inp(4) + (size_t)l * DM * MODS + (size_t)k0 * MODS + n;
#pragma unroll 8
        for (int kk = 0; kk < 128; ++kk) { const float w = W[(size_t)kk * MODS];
#pragma unroll
            for (int r = 0; r < 9; ++r) acc[r] += scr[r * 128 + kk] * w; }
#pragma unroll
        for (int r = 0; r < 9; ++r) atomicAdd(mod + (l * 9 + r) * MODS + n, acc[r]);
        LDS_WAIT(); asm volatile("" ::: "memory");
    }
    f32x2* apow = (f32x2*)(ws + WS_APOW); f32x2* bbar = (f32x2*)(ws + WS_BBAR);
    for (int i = (F.G - 1 - (int)blockIdx.x) * (NWAVES * 64) + f_tid; i < 64 * 2 * 64; i += F.NGT) {
        const int p = i & 63, dir = (i >> 6) & 1, g = i >> 7;
        const int pi = (dir * 64 + g) * 64 + p;
        const double lr = -fabs((double)inp(11)[pi]), li = (double)inp(12)[pi], dt = exp((double)inp(13)[dir * 64 + g]);
        for (int k = 0; k <= 16; ++k) { const double mag = exp(lr * dt * k), th = li * dt * k; apow[((g * 2 + dir) * 17 + k) * 64 + p] = (f32x2){(float)(mag * cos(th)), (float)(mag * sin(th))}; }
        const double mag = exp(lr * dt), ar1 = mag * cos(li * dt) - 1.0, ai = mag * sin(li * dt), den = lr * lr + li * li;
        const double cr = (ar1 * lr + ai * li) / den, ci = (ai * lr - ar1 * li) / den;
        const float* Br = inp(14) + (size_t)pi * 16; const float* Bi = inp(15) + (size_t)pi * 16;
#pragma unroll 4
        for (int c = 0; c < 16; ++c) { const double br = Br[c], bi = Bi[c]; bbar[((g * 2 + dir) * 64 + p) * 16 + c] = (f32x2){(float)(cr * br - ci * bi), (float)(cr * bi + ci * br)}; }
    }
}

template <bool SB> __device__ __forceinline__ void modnorm_rows(Frame& F, const void* src_lat, const void* src_ctx, int nrows, bf16* H, const float* gnorm, const float* modl, int shc, int scc, const float* part = nullptr, const float* pgate = nullptr, int row_begin = 0, int wave0 = 0) {
    LANE_IDS();
    if (F.gw >= wave0) for (int row = row_begin + (F.gw - wave0); row < nrows; row += F.NGW - wave0) {
        const bool isctx = row >= NLAT; const int b = isctx ? 8 : (row >> 12);
        const size_t roff = isctx ? (size_t)(row - NLAT) * DM : (size_t)row * DM; const void* sp = isctx ? src_ctx : src_lat;
        f32x4 v[4]; float ss = 0.f;
        if (SB) { const u32x2* xr = (const u32x2*)((const bf16*)sp + roff) + f_lane;
#pragma unroll
            for (int j = 0; j < 4; ++j) { const u32x2 r = xr[64 * j]; v[j] = (f32x4){__uint_as_float(r.x << 16), __uint_as_float(r.x & 0xffff0000u), __uint_as_float(r.y << 16), __uint_as_float(r.y & 0xffff0000u)}; } }
        else { const f32x4* xr = (const f32x4*)((const float*)sp + roff) + f_lane;
#pragma unroll
            for (int j = 0; j < 4; ++j) v[j] = xr[64 * j]; }
        if (part != nullptr && isctx) {
            const f32x4* p0 = (const f32x4*)(part + (size_t)(row - NLAT) * DM) + f_lane; const f32x4* p1 = p0 + (size_t)NCTX * DM / 4; const f32x4* g4p = (const f32x4*)pgate + f_lane;
#pragma unroll
            for (int j = 0; j < 4; ++j) v[j] += g4p[64 * j] * (p0[64 * j] + p1[64 * j]); }
#pragma unroll
        for (int j = 0; j < 4; ++j) ss += (v[j].x * v[j].x + v[j].y * v[j].y) + (v[j].z * v[j].z + v[j].w * v[j].w);
        const float rstd = rsqrtf(wave_sum(ss) * (1.0f / DM) + EPS);
        const f32x4* g4 = (const f32x4*)gnorm + f_lane; const f32x4* sh4 = (const f32x4*)(modl + b * MODS + shc * DM) + f_lane; const f32x4* sc4 = (const f32x4*)(modl + b * MODS + scc * DM) + f_lane;
        u32x2* o8 = (u32x2*)(H + (size_t)row * DM) + f_lane;
#pragma unroll
        for (int j = 0; j < 4; ++j) { const f32x4 y = v[j] * rstd * g4[64 * j] * (sc4[64 * j] + 1.0f) + sh4[64 * j];
            u32x2 w; w.x = cvt_pk_bf16(y.x, y.y); w.y = cvt_pk_bf16(y.z, y.w); o8[64 * j] = w; }
    }
}

__device__ __forceinline__ void p0b_tables(Frame& F, const Args& A, int t0) {
    LANE_IDS();
    const int tg = f_gtid - t0, tn = F.NGT - t0; if (tg < 0) return;
    unsigned char* ws = F.ws;
    const f32x2* apow = (const f32x2*)(ws + WS_APOW); const f32x2* bbar = (const f32x2*)(ws + WS_BBAR);
    float* Kc = (float*)(ws + WS_KC); bf16* WBT = (bf16*)(ws + WS_WBT); bf16* TBT = (bf16*)(ws + WS_TBT);
    const float* Cre = inp(16); const float* Cim = inp(17);
    for (int i = tg; i < 64 * 2 * 16 * 256; i += tn) {
        const int c = i & 15, cp = (i >> 4) & 15, k = (i >> 8) & 15, dir = (i >> 12) & 1, g = i >> 13;
        const f32x2* ap = apow + ((g * 2 + dir) * 17 + k) * 64; const f32x2* bb = bbar + (size_t)((g * 2 + dir) * 64) * 16 + c;
        const float* cr = Cre + ((size_t)(dir * 64 + g) * 16 + cp) * 64; const float* ci = Cim + ((size_t)(dir * 64 + g) * 16 + cp) * 64;
        float s = 0.f;
        for (int p = 0; p < 64; ++p) { const f32x2 a = ap[p], b = bb[p * 16]; const float xr = a.x * b.x - a.y * b.y, xi = a.x * b.y + a.y * b.x; s += cr[p] * xr - ci[p] * xi; }
        Kc[i] = s;
    }
    for (int i = tg; i < 64 * 256 * 32; i += tn) {
        const int c8 = i & 1, s = (i >> 1) & 15, n = (i >> 5) & 255, g = i >> 13, dir = n >> 7, comp = n & 127, p = comp & 63, im = comp >> 6;
        const f32x2 a = apow[((g * 2 + dir) * 17 + (dir ? s : 15 - s)) * 64 + p]; const f32x2* bb = bbar + (size_t)((g * 2 + dir) * 64 + p) * 16 + c8 * 8;
        float o[8];
#pragma unroll
        for (int j = 0; j < 8; ++j) { const f32x2 b = bb[j]; o[j] = im ? (a.x * b.y + a.y * b.x) : (a.x * b.x - a.y * b.y); }
        *(u32x4*)(WBT + ((size_t)(g * 256 + n) * 256 + s * 16 + c8 * 8)) = pack8f(o);
    }
    for (int i = tg; i < 64 * 256 * 32; i += tn) {
        const int q8 = i & 31, n = (i >> 5) & 255, g = i >> 13, tau = n >> 4, cp = n & 15, dir = q8 >> 4, comp0 = (q8 & 15) * 8, im = comp0 >> 6, p0 = comp0 & 63;
        const f32x2* ap = apow + ((g * 2 + dir) * 17 + (dir ? 16 - tau : tau + 1)) * 64 + p0;
        const float* cr = Cre + ((size_t)(dir * 64 + g) * 16 + cp) * 64 + p0; const float* ci = Cim + ((size_t)(dir * 64 + g) * 16 + cp) * 64 + p0;
        float o[8];
#pragma unroll
        for (int j = 0; j < 8; ++j) { const f32x2 a = ap[j]; o[j] = im ? -(cr[j] * a.y + ci[j] * a.x) : (cr[j] * a.x - ci[j] * a.y); }
        *(u32x4*)(TBT + ((size_t)(g * 256 + n) * 512 + 256 + dir * 128 + comp0)) = pack8f(o);
    }
}

__device__ __forceinline__ void p3_scan(Frame& F, const Args& A) {
    LANE_IDS();
    unsigned char* ws = F.ws;
    const f32x2* apow = (const f32x2*)(ws + WS_APOW); const float* Kc = (const float*)(ws + WS_KC); bf16* TBT = (bf16*)(ws + WS_TBT);
    const float* E = (const float*)(ws + WS_X); bf16* ACAT = (bf16*)(ws + WS_ACAT);
#define SCAN_K(seg, j) (dir ? ((seg) == 0 ? 15 - (j) : 271 - 16 * ((seg) - 1) - (j)) : 16 * (seg) + (j))
#define SCAN_LOAD(ER, EI, seg) do { _Pragma("unroll") for (int j = 0; j < 16; ++j) { const int k = SCAN_K(seg, j); ER[j] = Eb[(size_t)k * 256]; EI[j] = Eb[(size_t)k * 256 + 64]; } } while (0)
#define SCAN_STEP(ER, EI, seg) do { _Pragma("unroll") for (int j = 0; j < 16; ++j) { const int k = SCAN_K(seg, j); \
        Hb[(size_t)k * 512] = (bf16)(cvt_pk_bf16(hr, 0.f) & 0xffffu); Hb[(size_t)k * 512 + 64] = (bf16)(cvt_pk_bf16(hi, 0.f) & 0xffffu); \
        const float nr = a16.x * hr - a16.y * hi + ER[j], ni = a16.x * hi + a16.y * hr + EI[j]; hr = nr; hi = ni; } } while (0)
    if (F.wave < 4) for (int u = (int)blockIdx.x * 4 + F.wave; u < 64 * 8 * 2; u += F.G * 4) {
        const int dir = u & 1, b = (u >> 1) & 7, g = u >> 4, p = f_lane;
        const f32x2 a16 = apow[((g * 2 + dir) * 17 + 16) * 64 + p];
        const float* Eb = E + ((size_t)g * GROWS + b * NCH) * 256 + dir * 128 + p;
        bf16* Hb = ACAT + ((size_t)(g * GPAD + b * NCH)) * 512 + 256 + dir * 128 + p;
        float hr = 0.f, hi = 0.f;
        float er0[16], ei0[16], er1[16], ei1[16];
        SCAN_LOAD(er0, ei0, 0);
        for (int seg = 0; seg < 17; seg += 2) {
            if (seg + 1 < 17) SCAN_LOAD(er1, ei1, seg + 1);
            SCAN_STEP(er0, ei0, seg);
            if (seg + 1 < 17) { if (seg + 2 < 17) SCAN_LOAD(er0, ei0, seg + 2); SCAN_STEP(er1, ei1, seg + 1); }
        }
    }
#undef SCAN_K
#undef SCAN_LOAD
#undef SCAN_STEP
    const float* Dk = inp(18);
    for (int i = f_gtid; i < 64 * 256 * 32; i += F.NGT) {
        const int c8 = i & 1, s = (i >> 1) & 15, n = (i >> 5) & 255, g = i >> 13, tau = n >> 4, cp = n & 15;
        float o[8];
#pragma unroll
        for (int j = 0; j < 8; ++j) o[j] = 0.f;
        if (s <= tau) { const float* kf = Kc + ((size_t)((g * 2 + 0) * 16 + (tau - s)) * 16 + cp) * 16 + c8 * 8;
#pragma unroll
            for (int j = 0; j < 8; ++j) o[j] += kf[j]; }
        if (s >= tau) { const float* kb = Kc + ((size_t)((g * 2 + 1) * 16 + (s - tau)) * 16 + cp) * 16 + c8 * 8;
#pragma unroll
            for (int j = 0; j < 8; ++j) o[j] += kb[j]; }
        if (s == tau) { const float dv = Dk[g * 16 + cp];
#pragma unroll
            for (int j = 0; j < 8; ++j) if (c8 * 8 + j == cp) o[j] += dv; }
        *(u32x4*)(TBT + ((size_t)(g * 256 + n) * 512 + s * 16 + c8 * 8)) = pack8f(o);
    }
}

__device__ __forceinline__ void p12_lrnorm(Frame& F, const Args& A) {
    LANE_IDS();
    unsigned char* ws = F.ws;
    const bf16* PX = (const bf16*)(ws + WS_PX); bf16* QL = (bf16*)((unsigned char*)F.out + OUT_QL); bf16* CKV = (bf16*)(ws + WS_CKV); bf16* KPE = (bf16*)(ws + WS_KPE);
    const float* gqa = inp(22); const float* gkva = inp(23);
    constexpr int NR = 4;
    for (int row0 = F.gw; row0 < NTOK; row0 += NR * F.NGW) {
        bf16x8 qraw[NR]; u32x2 kraw[NR]; u32x4 praw[NR];
#pragma unroll
        for (int r = 0; r < NR; ++r) { const int row = row0 + r * F.NGW; if (row < NTOK) { const bf16* pr = PX + (size_t)row * DM;
            if (row < NLAT) qraw[r] = *(const bf16x8*)(pr + 8 * f_lane);
            kraw[r] = *(const u32x2*)(pr + QLR + 4 * f_lane);
            if (f_lane < 4) praw[r] = *(const u32x4*)(pr + QLR + KVLR + 8 * f_lane); } }
#pragma unroll
        for (int r = 0; r < NR; ++r) { const int row = row0 + r * F.NGW; if (row < NTOK) {
            if (row < NLAT) {
                float q[8]; unpack8(qraw[r], q); float ss = 0.f;
#pragma unroll
                for (int j = 0; j < 8; ++j) ss += q[j] * q[j];
                const float rstd = rsqrtf(wave_sum(ss) * (1.0f / QLR) + EPS);
#pragma unroll
                for (int j = 0; j < 8; ++j) q[j] = q[j] * rstd * gqa[8 * f_lane + j];
                *(u32x4*)(QL + (size_t)row * QLR + 8 * f_lane) = pack8f(q);
            }
            { const u32x2 raw = kraw[r]; float k[4];
              k[0] = __uint_as_float(raw.x << 16); k[1] = __uint_as_float(raw.x & 0xffff0000u); k[2] = __uint_as_float(raw.y << 16); k[3] = __uint_as_float(raw.y & 0xffff0000u);
              const float ss = (k[0] * k[0] + k[1] * k[1]) + (k[2] * k[2] + k[3] * k[3]);
              const float rstd = rsqrtf(wave_sum(ss) * (1.0f / KVLR) + EPS);
              const f32x4 gg = *(const f32x4*)(gkva + 4 * f_lane);
              u32x2 w; w.x = cvt_pk_bf16(k[0] * rstd * gg.x, k[1] * rstd * gg.y); w.y = cvt_pk_bf16(k[2] * rstd * gg.z, k[3] * rstd * gg.w);
              *(u32x2*)(CKV + (size_t)row * KVLR + 4 * f_lane) = w; }
            if (f_lane < 4) *(u32x4*)(KPE + (size_t)row * 32 + 8 * f_lane) = praw[r]; } }
    }
}

__device__ __forceinline__ void head_norm_rope_store(const bf16x8 (&raw)[12], const float* gw, bool rope, int l, bf16* dst, float oscale) {
    float ss = 0.f;
#pragma unroll
    for (int j = 0; j < 12; ++j) { float t[8]; unpack8(raw[j], t);
#pragma unroll
        for (int e = 0; e < 8; ++e) ss += t[e] * t[e]; }
    const float rstd = rsqrtf(ss * (1.0f / 96.0f) + EPS) * oscale;
#pragma unroll
    for (int j = 0; j < 8; ++j) { float t[8]; unpack8(raw[j], t);
#pragma unroll
        for (int e = 0; e < 8; ++e) t[e] = t[e] * rstd * gw[8 * j + e];
        *(u32x4*)(dst + 8 * j) = pack8f(t); }
    const float invf[8] = {1.0f, 0.31622776601683794f, 0.1f, 0.031622776601683794f, 0.01f, 0.0031622776601683794f, 0.001f, 0.00031622776601683794f};
#pragma unroll
    for (int ax = 0; ax < 2; ++ax) { float x1[8], x2[8]; unpack8(raw[8 + 2 * ax], x1); unpack8(raw[9 + 2 * ax], x2);
        const float pos = ax ? (float)(l & 63) : (float)(l >> 6);
#pragma unroll
        for (int e = 0; e < 8; ++e) { const float a = x1[e] * rstd * gw[64 + 16 * ax + e], b = x2[e] * rstd * gw[72 + 16 * ax + e];
            float cs = 1.f, sn = 0.f; if (rope) { const float ang = pos * invf[e]; cs = __cosf(ang); sn = __sinf(ang); }
            x1[e] = a * cs - b * sn; x2[e] = b * cs + a * sn; }
        *(u32x4*)(dst + 64 + 16 * ax) = pack8f(x1); *(u32x4*)(dst + 72 + 16 * ax) = pack8f(x2); }
}
__device__ __forceinline__ void p15_prep(Frame& F, const Args& A) {
    LANE_IDS();
    unsigned char* ws = F.ws;
    const bf16* KN = (const bf16*)(ws + WS_H); const bf16* KPE = (const bf16*)(ws + WS_KPE); bf16* KH = (bf16*)(ws + WS_KH);
    const float* gk = inp(27);
    for (int i = f_gtid; i < NTOK * NHEAD; i += F.NGT) {
        const int row = i >> 4, h = i & 15; const bf16* kn = KN + (size_t)row * DM + h * 64; const bf16* kp = KPE + (size_t)row * 32;
        bf16x8 raw[12];
#pragma unroll
        for (int j = 0; j < 8; ++j) raw[j] = *(const bf16x8*)(kn + 8 * j);
#pragma unroll
        for (int j = 0; j < 4; ++j) raw[8 + j] = *(const bf16x8*)(kp + 8 * j);
        int b, sp; pg8::row_to_bsp(row, b, sp);
        bf16* kd = KH + ((size_t)(b * NHEAD + h) * SPB + sp) * 128;
        head_norm_rope_store(raw, gk, row < NLAT, row & (SEQ - 1), kd, 1.0f);
        *(u32x4*)(kd + 96) = (u32x4){0x3F80u, 0u, 0u, 0u}; *(u32x4*)(kd + 104) = (u32x4){0u, 0u, 0u, 0u};
    }
}

namespace att {
using s16x4  = __attribute__((ext_vector_type(4))) short;
using f32x16 = __attribute__((ext_vector_type(16))) float;
constexpr int NW = 8, QBLK = 32, KVBLK = 64;
constexpr float SCALE = 0.10206207261596575f;
constexpr float THR = 8.f;
constexpr int LDQ = NHEAD * QKD, LDK = 128, LDV = VD, LDO = DM;
constexpr size_t SHM_V = KVBLK * 128 * 2, SHM_K = KVBLK * 128 * 2, SHM_ATTN = 3 * SHM_V + 3 * SHM_K + NW * 64 * 4;
#define KSWZ(row, colB) ((row) * 256 + ((colB) ^ (((row) & 7) << 4)))
#define SBAR() __builtin_amdgcn_sched_barrier(0)
__device__ __forceinline__ int crow(int r, int hi) { return (r & 3) + 8 * (r >> 2) + 4 * hi; }
__device__ __forceinline__ unsigned cvtpk(float lo, float hi) { unsigned r; asm volatile("v_cvt_pk_bf16_f32 %0, %1, %2" : "=v"(r) : "v"(lo), "v"(hi)); return r; }
__device__ __forceinline__ void partialSM(f32x16& p0) {
#pragma unroll
  for (int r = 0; r < 16; ++r) p0[r] = __builtin_amdgcn_exp2f(p0[r]);
}
__device__ __forceinline__ void finishSM(f32x16& p0, f32x16& p1, float& l_reg, bf16x8& pa0, bf16x8& pa1, bf16x8& pa2, bf16x8& pa3) {
#pragma unroll
  for (int r = 0; r < 16; ++r) p1[r] = __builtin_amdgcn_exp2f(p1[r]);
  float ps = 0;
#pragma unroll
  for (int r = 0; r < 16; ++r) ps += p0[r];
#pragma unroll
  for (int r = 0; r < 16; ++r) ps += p1[r];
  l_reg += ps;
#define PK4(P, BASE, OUT) do { unsigned a0 = cvtpk(P[BASE + 0], P[BASE + 1]), a1 = cvtpk(P[BASE + 2], P[BASE + 3]);   \
    unsigned b0 = cvtpk(P[BASE + 4], P[BASE + 5]), b1 = cvtpk(P[BASE + 6], P[BASE + 7]);                              \
    auto r0 = __builtin_amdgcn_permlane32_swap(a0, b0, false, false); auto r1 = __builtin_amdgcn_permlane32_swap(a1, b1, false, false); \
    u32x4 w = {r0[0], r1[0], r0[1], r1[1]}; OUT = *reinterpret_cast<bf16x8*>(&w); } while (0)
  PK4(p0, 0, pa0); PK4(p0, 8, pa1); PK4(p1, 0, pa2); PK4(p1, 8, pa3);
#undef PK4
}
template <int ND> __device__ __forceinline__ void qkt(f32x16& p0, f32x16& p1, const bf16* Ks, const bf16x8* qr, int r32, int hi) {
  p0 = f32x16{}; p1 = f32x16{};
#pragma unroll
  for (int d0 = 0; d0 < ND; ++d0) { int cb = (d0 * 16 + hi * 8) * 2;
    bf16x8 b0 = *reinterpret_cast<const bf16x8*>((const char*)Ks + KSWZ(r32, cb));
    bf16x8 b1 = *reinterpret_cast<const bf16x8*>((const char*)Ks + KSWZ(32 + r32, cb));
    p0 = __builtin_amdgcn_mfma_f32_32x32x16_bf16(b0, qr[d0], p0, 0, 0, 0);
    p1 = __builtin_amdgcn_mfma_f32_32x32x16_bf16(b1, qr[d0], p1, 0, 0, 0); }
}
__device__ __forceinline__ int v_st(int k, int c) { const int kk = (k & ~0xC) | ((k & 4) << 1) | ((k & 8) >> 1); return ((kk >> 3) * 4 + (c >> 5)) * 512 + ((kk & 7) * 32 + (c & 31)) * 2; }
__device__ __forceinline__ int v_rd_base(int lane) { return ((lane & 3) << 3) | (((lane >> 2) & 3) << 6) | (((lane >> 4) & 1) << 5) | (((lane >> 5) & 1) << 8); }
constexpr int v_rd_off(int d0, int ks, int half) { return d0 * 512 + ks * 4096 + half * 2048; }
template <int OFF> __device__ __forceinline__ s16x4 tr_read(int vb) {
  s16x4 r; asm volatile("ds_read_b64_tr_b16 %0, %1 offset:%2" : "=&v"(r) : "v"(vb), "i"(OFF) : "memory"); return r;
}
template <int D0> __device__ __forceinline__ void pv_one(f32x16& od, int vb, bf16x8 pa0, bf16x8 pa1, bf16x8 pa2, bf16x8 pa3) {
  const s16x4 l0 = tr_read<v_rd_off(D0, 0, 0)>(vb), h0 = tr_read<v_rd_off(D0, 0, 1)>(vb), l1 = tr_read<v_rd_off(D0, 1, 0)>(vb), h1 = tr_read<v_rd_off(D0, 1, 1)>(vb);
  const s16x4 l2 = tr_read<v_rd_off(D0, 2, 0)>(vb), h2 = tr_read<v_rd_off(D0, 2, 1)>(vb), l3 = tr_read<v_rd_off(D0, 3, 0)>(vb), h3 = tr_read<v_rd_off(D0, 3, 1)>(vb);
  asm volatile("s_waitcnt lgkmcnt(0)" ::: "memory"); SBAR();
#define PK(L, H) (bf16x8){L[0], L[1], L[2], L[3], H[0], H[1], H[2], H[3]}
  od = __builtin_amdgcn_mfma_f32_32x32x16_bf16(pa0, PK(l0, h0), od, 0, 0, 0);
  od = __builtin_amdgcn_mfma_f32_32x32x16_bf16(pa1, PK(l1, h1), od, 0, 0, 0);
  od = __builtin_amdgcn_mfma_f32_32x32x16_bf16(pa2, PK(l2, h2), od, 0, 0, 0);
  od = __builtin_amdgcn_mfma_f32_32x32x16_bf16(pa3, PK(l3, h3), od, 0, 0, 0);
#undef PK
}
__device__ __forceinline__ void pv_d0(f32x16* o, int vb, bf16x8 pa0, bf16x8 pa1, bf16x8 pa2, bf16x8 pa3) {
  pv_one<0>(o[0], vb, pa0, pa1, pa2, pa3); pv_one<1>(o[1], vb, pa0, pa1, pa2, pa3);
}
template <bool SHIFT> __device__ __forceinline__ void attn_dense_body(const bf16* __restrict__ Qb, const bf16* __restrict__ Kh, const bf16* __restrict__ Vh, bf16* __restrict__ Ob, int seq, char* lds, LAS unsigned char* ldsl, float negB, const float* __restrict__ gq, int qpos0) {
  const int tid = threadIdx.x, wid = tid >> 6, lane = tid & 63, r32 = lane & 31, hi = lane >> 5;
  bf16* V_lds = (bf16*)lds; bf16* K_lds = (bf16*)(lds + 3 * SHM_V);
  float* wsf = (float*)(lds + 3 * SHM_V + 3 * SHM_K) + wid * 64; float* li_l = wsf;
  float l_reg = 0; f32x16 o[2] = {}; bf16x8 qr[7];
  const bf16* Qw = Qb + (long)(wid * QBLK + r32) * LDQ + hi * 8;
  asm volatile("" : "+s"(gq));
  { float ss = 0.f;
#pragma unroll
    for (int d0 = 0; d0 < 6; ++d0) { qr[d0] = *reinterpret_cast<const bf16x8*>(Qw + d0 * 16);
#pragma unroll
      for (int e = 0; e < 8; ++e) { const float f = __uint_as_float(((unsigned)(unsigned short)qr[d0][e]) << 16); ss += f * f; } }
    { auto rr = __builtin_amdgcn_permlane32_swap(__float_as_uint(ss), __float_as_uint(ss), false, false); ss = __uint_as_float(rr[0]) + __uint_as_float(rr[1]); }
    const float rstd = rsqrtf(ss * (1.0f / 96.0f) + EPS) * (SCALE * 1.4426950408889634f);
    int lpos = qpos0 + wid * QBLK + r32; asm volatile("" : "+v"(lpos));
    const float invf[8] = {1.0f, 0.31622776601683794f, 0.1f, 0.031622776601683794f, 0.01f, 0.0031622776601683794f, 0.001f, 0.00031622776601683794f};
#pragma unroll
    for (int d0 = 0; d0 < 6; ++d0) { float f[8];
      const f32x4 g0 = *reinterpret_cast<const f32x4*>(gq + d0 * 16 + hi * 8), g1 = *reinterpret_cast<const f32x4*>(gq + d0 * 16 + hi * 8 + 4);
#pragma unroll
      for (int e = 0; e < 8; ++e) f[e] = __uint_as_float(((unsigned)(unsigned short)qr[d0][e]) << 16) * rstd * (e < 4 ? g0[e & 3] : g1[e & 3]);
      if (d0 >= 4) { const float pos = (d0 == 5) ? (float)(lpos & 63) : (float)(lpos >> 6);
#pragma unroll
        for (int e = 0; e < 8; ++e) { const float own = f[e];
          auto rr = __builtin_amdgcn_permlane32_swap(__float_as_uint(own), __float_as_uint(own), false, false);
          const float other = hi ? __uint_as_float(rr[0]) : __uint_as_float(rr[1]);
          const float ang = pos * invf[e], cs = __cosf(ang), sn = __sinf(ang);
          f[e] = own * cs + (hi ? other : -other) * sn; } }
      u32x4 w = pack8f(f); qr[d0] = *reinterpret_cast<bf16x8*>(&w);
      asm volatile("" : "+v"(qr[d0])); }
  }
  { u32x4 w = {hi == 0 ? (cvtpk(negB, 0.f) & 0xffffu) : 0u, 0u, 0u, 0u}; qr[6] = *reinterpret_cast<bf16x8*>(&w); }
  const int vb0 = (int)(uintptr_t)V_lds + v_rd_base(lane);
  const int widu = __builtin_amdgcn_readfirstlane(wid);
  const int kr0 = 8 * wid + (lane >> 4), kr1 = kr0 + 4, kp = lane & 15;
  const int vkk = 8 * wid + ((lane & 31) >> 2), vk = (vkk & ~0xC) | ((vkk & 4) << 1) | ((vkk & 8) >> 1), vcc = 32 * (lane >> 5) + 8 * (lane & 3);
  const bf16* kg0 = Kh + (long)kr0 * LDK + ((kp ^ (kr0 & 7)) * 8); const bf16* kg1 = Kh + (long)kr1 * LDK + ((kp ^ (kr1 & 7)) * 8); const bf16* vg = Vh + (long)vk * LDV + vcc;
  LAS unsigned char* const lV = ldsl; LAS unsigned char* const lK = ldsl + 3 * SHM_V;
#define DMA(b, k0) do { \
    __builtin_amdgcn_global_load_lds((const unsigned*)(kg0 + (long)(k0) * LDK), (LAS unsigned*)(lK + (b) * (int)SHM_K + (2 * widu) * 1024), 16, 0, 0); \
    __builtin_amdgcn_global_load_lds((const unsigned*)(kg1 + (long)(k0) * LDK), (LAS unsigned*)(lK + (b) * (int)SHM_K + (2 * widu + 1) * 1024), 16, 0, 0); \
    __builtin_amdgcn_global_load_lds((const unsigned*)(vg + (long)(k0) * LDV), (LAS unsigned*)(lV + (b) * (int)SHM_V + (4 * widu) * 512), 16, 0, 0); } while (0)
  f32x16 pA0, pA1, pB0, pB1; bf16x8 pa0, pa1, pa2, pa3; const int NT = seq / KVBLK;
  DMA(0, 0); asm volatile("s_waitcnt vmcnt(0)" ::: "memory"); __syncthreads();
  DMA(1, KVBLK);
  qkt<SHIFT ? 7 : 6>(pA0, pA1, K_lds, qr, r32, hi); partialSM(pA0);
  asm volatile("s_waitcnt vmcnt(0)" ::: "memory"); __syncthreads();
  int bv = 0, bk = 1, bw = 2;
#define ROT() do { const int t_ = bv; bv = bk; bk = bw; bw = t_; } while (0)
  for (int j = 1; j + 1 < NT; j += 2) {
    DMA(bw, (j + 1) * KVBLK);
    SBAR(); qkt<SHIFT ? 7 : 6>(pB0, pB1, (bf16*)((char*)K_lds + bk * SHM_K), qr, r32, hi);
    finishSM(pA0, pA1, l_reg, pa0, pa1, pa2, pa3); SBAR();
    pv_d0(o, vb0 + bv * (int)SHM_V, pa0, pa1, pa2, pa3); partialSM(pB0);
    asm volatile("s_waitcnt vmcnt(0)" ::: "memory"); __syncthreads(); ROT();
    DMA(bw, (j + 2) * KVBLK);
    SBAR(); qkt<SHIFT ? 7 : 6>(pA0, pA1, (bf16*)((char*)K_lds + bk * SHM_K), qr, r32, hi);
    finishSM(pB0, pB1, l_reg, pa0, pa1, pa2, pa3); SBAR();
    pv_d0(o, vb0 + bv * (int)SHM_V, pa0, pa1, pa2, pa3); partialSM(pA0);
    asm volatile("s_waitcnt vmcnt(0)" ::: "memory"); __syncthreads(); ROT();
  }
  SBAR(); qkt<SHIFT ? 7 : 6>(pB0, pB1, (bf16*)((char*)K_lds + bk * SHM_K), qr, r32, hi);
  finishSM(pA0, pA1, l_reg, pa0, pa1, pa2, pa3); SBAR();
  pv_d0(o, vb0 + bv * (int)SHM_V, pa0, pa1, pa2, pa3); partialSM(pB0);
  ROT();
  finishSM(pB0, pB1, l_reg, pa0, pa1, pa2, pa3); SBAR();
  pv_d0(o, vb0 + bv * (int)SHM_V, pa0, pa1, pa2, pa3);
#undef ROT
#undef DMA
  { auto rr = __builtin_amdgcn_permlane32_swap(__float_as_uint(l_reg), __float_as_uint(l_reg), false, false); l_reg = __uint_as_float(rr[0]) + __uint_as_float(rr[1]); }
  if (hi == 0) li_l[r32] = l_reg; asm volatile("s_waitcnt lgkmcnt(0)" ::: "memory");
  float rli[16];
#pragma unroll
  for (int r = 0; r < 16; ++r) rli[r] = __builtin_amdgcn_rcpf(li_l[crow(r, hi)]);
  bf16* Ow = Ob + (long)(wid * QBLK) * LDO;
#pragma unroll
  for (int r = 0; r < 16; ++r) { int orow = crow(r, hi);
#pragma unroll
    for (int d0 = 0; d0 < 2; ++d0) Ow[(long)orow * LDO + d0 * 32 + r32] = (bf16)(cvtpk(o[d0][r] * rli[r], 0.f) & 0xffffu); }
  __syncthreads();
}
}

#define XB_TMO      128
#define XB_XCNT(j)  (256  + 64 * (j))
#define XB_XSUB(j)  (1280 + 64 * (j))
#define XB_XGEN(j)  (2304 + 64 * (j))
#define XB_TOP      3328
#define XB_TOPGEN   3392
#define XCD_BAR_WORDS 3456
#define XB_SPIN_CAP (1u << 18)

__device__ __forceinline__ unsigned xb_ld(unsigned* p)              { return __hip_atomic_load(p, __ATOMIC_RELAXED, __HIP_MEMORY_SCOPE_AGENT); }
__device__ __forceinline__ unsigned xb_add(unsigned* p, unsigned v) { return __hip_atomic_fetch_add(p, v, __ATOMIC_RELAXED, __HIP_MEMORY_SCOPE_AGENT); }
__device__ __forceinline__ unsigned xb_xcc_id() { return (unsigned)__builtin_amdgcn_s_getreg((3 << 11) | 20) & 0xFu; }
#define XB_SPIN(cond, bar) do { unsigned _sp = 0; while (cond) { __builtin_amdgcn_s_sleep(1); \
    if ((++_sp & 255u) == 0u) { if (xb_ld(&(bar)[XB_TMO])) break; if (_sp > XB_SPIN_CAP) { atomicAdd(&(bar)[XB_TMO], 1u); break; } } } } while (0)

struct XcdBarrier {
    unsigned* bar; unsigned x;
    volatile LAS unsigned* st;
};

__device__ __forceinline__ XcdBarrier xcd_barrier_post(unsigned* bar, volatile LAS unsigned* st) {
    XcdBarrier b; b.bar = bar; b.x = xb_xcc_id(); b.st = st;
    if (threadIdx.x == 0) (void)xb_add(&bar[XB_XCNT(b.x)], 1u);
    return b;
}
__device__ __forceinline__ void xcd_barrier_complete(unsigned* bar, unsigned x, unsigned& nloc, unsigned& nx) {
    const unsigned G = gridDim.x * gridDim.y * gridDim.z;
    unsigned sum, cnt, mine, sp = 0u;
    for (;;) {
        sum = 0u; cnt = 0u; mine = 0u;
#pragma unroll
        for (unsigned j = 0; j < 16; ++j) { const unsigned c = xb_ld(&bar[XB_XCNT(j)]); sum += c; cnt += (c > 0u) ? 1u : 0u; mine = (j == x) ? c : mine; }
        if (sum == G) break;
        __builtin_amdgcn_s_sleep(1);
        if ((++sp & 255u) == 0u) { if (xb_ld(&bar[XB_TMO])) break; if (sp > XB_SPIN_CAP) { atomicAdd(&bar[XB_TMO], 1u); break; } }
    }
    nloc = mine > 0u ? mine : 1u; nx = cnt > 0u ? cnt : 1u;
}

__device__ __forceinline__ void xcd_barrier(const XcdBarrier& b) {
    asm volatile("s_waitcnt vmcnt(0)" ::: "memory");
    __syncthreads();
    if (threadIdx.x == 0) {
        unsigned* bar = b.bar;
        __builtin_amdgcn_s_waitcnt(0);
        unsigned nloc = b.st[0], nx = b.st[1];
        if (nloc == 0u) { xcd_barrier_complete(bar, b.x, nloc, nx); b.st[0] = nloc; b.st[1] = nx; }
        const unsigned old = xb_add(&bar[XB_XSUB(b.x)], 1u);
        const unsigned gen = old / nloc;
        if (old + 1u == (gen + 1u) * nloc) {
            __builtin_amdgcn_fence(__ATOMIC_RELEASE, "agent");
            asm volatile("s_waitcnt vmcnt(0)" ::: "memory");
            const unsigned og = xb_add(&bar[XB_TOP], 1u);
            const unsigned tg = og / nx;
            if (og + 1u == (tg + 1u) * nx) xb_add(&bar[XB_TOPGEN], 1u);
            else XB_SPIN(xb_ld(&bar[XB_TOPGEN]) == tg, bar);
            __builtin_amdgcn_fence(__ATOMIC_ACQUIRE, "agent");
            xb_add(&bar[XB_XGEN(b.x)], 1u);
            asm volatile("s_waitcnt vmcnt(0)" ::: "memory");
        } else {
            XB_SPIN(xb_ld(&bar[XB_XGEN(b.x)]) == gen, bar);
            __builtin_amdgcn_fence(__ATOMIC_ACQUIRE, "agent");
            asm volatile("s_waitcnt vmcnt(0)" ::: "memory");
        }
    }
    __syncthreads();
}


constexpr int NPHASE = 21;
__device__ __forceinline__ const CAS Args* kargs() { const CAS Args* p = (const CAS Args*)__builtin_amdgcn_kernarg_segment_ptr(); asm volatile("" : "+s"(p)); return p; }
__global__ void __launch_bounds__(NWAVES * 64, 2) mk_fwd(Args args) {
    extern __shared__ __attribute__((aligned(16))) unsigned char lds[];
    cg::grid_group grid = cg::this_grid();
    Frame F;
    F.lds = (LAS unsigned char*)lds;
    F.wave = __builtin_amdgcn_readfirstlane((int)threadIdx.x >> 6);
    F.G = gridDim.x; F.gw = blockIdx.x * NWAVES + F.wave; F.NGW = F.G * NWAVES; F.NGT = F.G * NWAVES * 64;
#ifndef PH_MASK
#define PH_MASK 0xffffffffu
#endif
#define IN(k) ((((PH_MASK) >> (k)) & 1u) && kargs()->ph_lo <= (k) && (k) < kargs()->ph_hi)
#ifndef PROBE_REP_MASK
#define PROBE_REP_MASK 0u
#endif
#define PH_REPS(k) ((((PROBE_REP_MASK) >> (k)) & 1u) ? 2 : 1)
#define SEAM(k) do { if (IN((k) + 1)) xcd_barrier(xbar); } while (0)
#define PH_PTRS() unsigned char* ws = kargs()->ws; F.ws = ws; F.out = kargs()->out; float* mod = (float*)(ws + WS_MOD); const float* mod1 = mod + 9 * MODS; bf16* X = (bf16*)(ws + WS_X);     bf16* H = (bf16*)(ws + WS_H); (void)mod; (void)mod1; (void)X; (void)H
    const int bx = blockIdx.x;
    volatile LAS unsigned* bst = (volatile LAS unsigned*)(F.lds + 131072 + 64);
    if (threadIdx.x == 0) { bst[0] = 0u; bst[1] = 0u; }
    __syncthreads();
    const XcdBarrier xbar = xcd_barrier_post((unsigned*)(kargs()->ws + WS_BAR), bst);
    if (kargs()->ph_hi > 1000) grid.sync();
#if defined(PROBE_SYNCS)
    if (kargs()->ph_hi - kargs()->ph_lo > 1) for (int i = 0; i < PROBE_SYNCS; ++i) xcd_barrier(xbar);
#endif

    if (IN(0)) for (int rep_ = 0; rep_ < PH_REPS(0); ++rep_) { PH_PTRS(); p0a(F, args); if (rep_ == PH_REPS(0) - 1) SEAM(0); }
    if (IN(1)) for (int rep_ = 0; rep_ < PH_REPS(1); ++rep_) { PH_PTRS(); modnorm_rows<false>(F, inp(0), inp(2), NTOK, H, inp(6), mod, 0, 1); if (rep_ == PH_REPS(1) - 1) SEAM(1); }
    const int NCB0 = (F.G >= 128) ? 32 : 0;
    if (IN(2)) for (int rep_ = 0; rep_ < PH_REPS(2); ++rep_) { PH_PTRS();
        { pg8::Gemm g{H, (const bf16*)(ws + WS_W_S5IN), NLAT, DM, DM, DM}; pg8::StaticOrder S; S.init(NLAT, DM, F.G, bx);
          pg8::EpiU E{(bf16*)(ws + WS_ACAT)};
          pg8::gemm_phase<pg8::EpiU, pg8::StaticOrder, true, true>(F.lds, g, S, E); }
        if (bx < NCB0 || NCB0 == 0) {
            pg8::Gemm g{H + (size_t)NLAT * DM, (const bf16*)(ws + WS_W_S5IN), NCTX, DM, DM, DM}; pg8::StaticOrder S; S.init(NCTX, DM, F.G, bx);
            pg8::EpiU E{(bf16*)(ws + WS_ACAT), 128};
            pg8::gemm_phase<pg8::EpiU, pg8::StaticOrder, true, true>(F.lds, g, S, E); }
        if (bx >= NCB0) p0b_tables(F, args, NCB0 * NWAVES * 64);
        if (rep_ == PH_REPS(2) - 1) SEAM(2); }
    if (IN(3)) for (int rep_ = 0; rep_ < PH_REPS(3); ++rep_) { PH_PTRS();
        pg8::Gemm g{(const bf16*)(ws + WS_ACAT), (const bf16*)(ws + WS_WBT), 64 * GPAD, 64 * 256, 256, 512}; pg8::GroupOrder S{F.G, bx};
        pg8::EpiE E{(float*)(ws + WS_X)};
        pg8::gemm_phase<pg8::EpiE, pg8::GroupOrder, true, true>(F.lds, g, S, E); if (rep_ == PH_REPS(3) - 1) SEAM(3); }
    if (IN(4)) for (int rep_ = 0; rep_ < PH_REPS(4); ++rep_) { PH_PTRS(); p3_scan(F, args); if (rep_ == PH_REPS(4) - 1) SEAM(4); }
    if (IN(5)) for (int rep_ = 0; rep_ < PH_REPS(5); ++rep_) { PH_PTRS();
        pg8::Gemm g{(const bf16*)(ws + WS_ACAT), (const bf16*)(ws + WS_TBT), 64 * GPAD, 64 * 256, 512, 512}; pg8::GroupOrder S{F.G, bx};
        pg8::EpiY E{H};
        pg8::gemm_phase<pg8::EpiY, pg8::GroupOrder, true, true>(F.lds, g, S, E); if (rep_ == PH_REPS(5) - 1) SEAM(5); }
    if (IN(6)) for (int rep_ = 0; rep_ < PH_REPS(6); ++rep_) { PH_PTRS();
        pg8::Gemm g{H, (const bf16*)(ws + WS_W_GLU), NTOK, 2 * DM, DM, DM}; pg8::StaticOrder S; S.init(NTOK, 2 * DM, F.G, bx);
        pg8::EpiGate<0> E{(bf16*)(ws + WS_G), DM};
        pg8::gemm_phase<pg8::EpiGate<0>, pg8::StaticOrder, true, true>(F.lds, g, S, E); if (rep_ == PH_REPS(6) - 1) SEAM(6); }
    const int NCB = (F.G >= 128) ? 32 : 0;
    if (IN(7)) for (int rep_ = 0; rep_ < PH_REPS(7); ++rep_) { PH_PTRS();
        pg8::Gemm g{(const bf16*)(ws + WS_G), (const bf16*)(ws + WS_W_S5OUT), NLAT, DM, DM, DM}; pg8::StaticOrder S; S.init(NLAT, DM, F.G, bx);
        pg8::EpiRes<false, true> E{inp(0), inp(2), X, X + (size_t)NLAT * DM, mod + 2 * DM};
        pg8::gemm_phase<pg8::EpiRes<false, true>, pg8::StaticOrder, true, true>(F.lds, g, S, E); if (rep_ == PH_REPS(7) - 1) SEAM(7); }
    if (IN(8)) for (int rep_ = 0; rep_ < PH_REPS(8); ++rep_) { PH_PTRS();
        if (bx < NCB || NCB == 0) {
            pg8::Gemm g{(const bf16*)(ws + WS_G) + (size_t)NLAT * DM, (const bf16*)(ws + WS_W_S5OUT), NCTX, DM, DM, DM}; pg8::StaticOrder S; S.init(NCTX, DM, F.G, bx);
            pg8::EpiRes<false, true> E{inp(0), inp(2), X, X + (size_t)NLAT * DM, mod + 2 * DM, NLAT};
            pg8::gemm_phase<pg8::EpiRes<false, true>, pg8::StaticOrder, true, true>(F.lds, g, S, E); }
        if (bx >= NCB) modnorm_rows<true>(F, X, X + (size_t)NLAT * DM, NLAT, H, inp(7), mod, 3, 4, nullptr, nullptr, 0, NCB * NWAVES);
        xcd_barrier(xbar);
        modnorm_rows<true>(F, X, X + (size_t)NLAT * DM, NTOK, H, inp(7), mod, 3, 4, nullptr, nullptr, NLAT, 0);
        if (rep_ == PH_REPS(8) - 1) SEAM(8); }
    if (IN(9)) for (int rep_ = 0; rep_ < PH_REPS(9); ++rep_) { PH_PTRS();
        pg8::Gemm g{H, (const bf16*)(ws + WS_W_FFIN0), NTOK, 2 * FH, DM, DM}; pg8::StaticOrder S; S.init(NTOK, 2 * FH, F.G, bx);
        pg8::EpiGate<1> E{(bf16*)(ws + WS_A1), FH};
        pg8::gemm_phase<pg8::EpiGate<1>, pg8::StaticOrder, true, true>(F.lds, g, S, E); if (rep_ == PH_REPS(9) - 1) SEAM(9); }
    if (IN(10)) for (int rep_ = 0; rep_ < PH_REPS(10); ++rep_) { PH_PTRS();
        pg8::Gemm g{(const bf16*)(ws + WS_A1), (const bf16*)(ws + WS_W_FFOUT0), NLAT, DM, FH, FH}; pg8::StaticOrder S; S.init(NLAT, DM, F.G, bx);
        pg8::EpiRes<true, true> E{X, X, X, X, mod + 5 * DM};
        pg8::gemm_phase<pg8::EpiRes<true, true>, pg8::StaticOrder, true, true>(F.lds, g, S, E); if (rep_ == PH_REPS(10) - 1) SEAM(10); }
    if (IN(11)) for (int rep_ = 0; rep_ < PH_REPS(11); ++rep_) { PH_PTRS();
        if (bx < 2 * NCB || NCB == 0) {
#pragma unroll
            for (int sl = 0; sl < 2; ++sl) {
              pg8::Gemm g{(const bf16*)(ws + WS_A1) + (size_t)NLAT * FH + sl * (FH / 2), (const bf16*)(ws + WS_W_FFOUT0) + sl * (FH / 2), NCTX, DM, FH / 2, FH, FH};
              pg8::StaticOrder S; S.init(NCTX, DM, F.G, (bx + F.G - 32 * sl) % F.G);
              pg8::EpiPart E{(float*)(ws + WS_PPART) + (size_t)sl * NCTX * DM};
              pg8::gemm_phase<pg8::EpiPart, pg8::StaticOrder, true, true>(F.lds, g, S, E); } }
        if (bx >= 2 * NCB) modnorm_rows<true>(F, X, X + (size_t)NLAT * DM, NLAT, H, inp(6) + DM, mod1, 0, 1, nullptr, nullptr, 0, 2 * NCB * NWAVES);
        xcd_barrier(xbar);
        modnorm_rows<true>(F, X, X + (size_t)NLAT * DM, NTOK, H, inp(6) + DM, mod1, 0, 1, (const float*)(ws + WS_PPART), mod + 8 * MODS + 5 * DM, NLAT, 0);
        if (rep_ == PH_REPS(11) - 1) SEAM(11); }
    if (IN(12)) for (int rep_ = 0; rep_ < PH_REPS(12); ++rep_) { PH_PTRS();
        pg8::Gemm g{H, (const bf16*)(ws + WS_W_MLAIN), NTOK, DM, DM, DM}; pg8::StaticOrder S; S.init(NTOK, DM, F.G, bx);
        pg8::EpiPlain E{(bf16*)(ws + WS_PX), DM};
        pg8::gemm_phase<pg8::EpiPlain, pg8::StaticOrder, true, true>(F.lds, g, S, E); if (rep_ == PH_REPS(12) - 1) SEAM(12); }
    if (IN(13)) for (int rep_ = 0; rep_ < PH_REPS(13); ++rep_) { PH_PTRS(); p12_lrnorm(F, args); if (rep_ == PH_REPS(13) - 1) SEAM(13); }
    if (IN(14)) for (int rep_ = 0; rep_ < PH_REPS(14); ++rep_) { PH_PTRS();
        { pg8::Gemm g{(const bf16*)((unsigned char*)F.out + OUT_QL), (const bf16*)(ws + WS_W_QB), NLAT, NHEAD * QKD, QLR, QLR}; pg8::StaticOrder S; S.init(NLAT, NHEAD * QKD, F.G, bx);
          pg8::EpiPlain E{(bf16*)F.out, NHEAD * QKD};
          pg8::gemm_phase<pg8::EpiPlain, pg8::StaticOrder, true, true>(F.lds, g, S, E); }
        { pg8::Gemm g{(const bf16*)(ws + WS_CKV), (const bf16*)(ws + WS_W_KVB), NTOK, 2048, KVLR, KVLR}; pg8::StaticOrder S; S.init(NTOK, 2048, F.G, bx);
          pg8::EpiKV E{(bf16*)(ws + WS_KH), (bf16*)(ws + WS_VH), (const bf16*)(ws + WS_KPE), inp(27)};
          pg8::gemm_phase<pg8::EpiKV, pg8::StaticOrder, true, true>(F.lds, g, S, E); }
        if (rep_ == PH_REPS(14) - 1) SEAM(14); }
    if (IN(16)) for (int rep_ = 0; rep_ < PH_REPS(16); ++rep_) { PH_PTRS();
        const int vcu = (F.G % 8 == 0) ? (bx % 8) * (F.G / 8) + bx / 8 : bx;
        float negB;
        { const float* gq = inp(26); const float* gk = inp(27); const int l = tid_() & 63; float a = fabsf(gq[l]), c = fabsf(gk[l]);
          if (l < 32) { a = fmaxf(a, fabsf(gq[64 + l])); c = fmaxf(c, fabsf(gk[64 + l])); }
#pragma unroll
          for (int o = 1; o < 64; o <<= 1) { a = fmaxf(a, __shfl_xor(a, o)); c = fmaxf(c, __shfl_xor(c, o)); }
          negB = -(96.0f * 0.10206207261596575f * 1.4426950408889634f * 1.01f) * a * c;
          negB = __uint_as_float(__builtin_amdgcn_readfirstlane(__float_as_uint(negB))); }
#if defined(PROBE_ATT2)
        for (int rep = 0; rep < 2; ++rep)
#endif
        for (int u = vcu; u < NBATCH * NHEAD * (SEQ / 256); u += F.G) {
            const int bh = u >> 4, qb = u & 15, b = bh >> 4, h = bh & 15;
            if (negB < -100.0f) att::attn_dense_body<true>((const bf16*)F.out + ((size_t)(b * SEQ + qb * 256)) * (NHEAD * QKD) + h * QKD,
                                 (const bf16*)(ws + WS_KH) + (size_t)bh * SPB * 128, (const bf16*)(ws + WS_VH) + (size_t)bh * SPB * VD,
                                 H + ((size_t)(b * SEQ + qb * 256)) * DM + h * VD, SPB, (char*)lds, F.lds, negB, inp(26), qb * 256);
            else att::attn_dense_body<false>((const bf16*)F.out + ((size_t)(b * SEQ + qb * 256)) * (NHEAD * QKD) + h * QKD,
                                 (const bf16*)(ws + WS_KH) + (size_t)bh * SPB * 128, (const bf16*)(ws + WS_VH) + (size_t)bh * SPB * VD,
                                 H + ((size_t)(b * SEQ + qb * 256)) * DM + h * VD, SPB, (char*)lds, F.lds, negB, inp(26), qb * 256);
        }
        if (rep_ == PH_REPS(16) - 1) SEAM(16); }
    if (IN(17)) for (int rep_ = 0; rep_ < PH_REPS(17); ++rep_) { PH_PTRS();
        pg8::Gemm g{H, (const bf16*)(ws + WS_W_O), NLAT, DM, DM, DM}; pg8::StaticOrder S; S.init(NLAT, DM, F.G, bx);
        bf16* X3 = X + (size_t)NTOK * DM;
        pg8::EpiRes<true, true> E{X, X, X3, X3, mod1 + 2 * DM};
        pg8::gemm_phase<pg8::EpiRes<true, true>, pg8::StaticOrder, true, true>(F.lds, g, S, E); if (rep_ == PH_REPS(17) - 1) SEAM(17); }
    if (IN(18)) for (int rep_ = 0; rep_ < PH_REPS(18); ++rep_) { PH_PTRS(); modnorm_rows<true>(F, X + (size_t)NTOK * DM, X + (size_t)NTOK * DM, NLAT, H, inp(7) + DM, mod1, 3, 4); if (rep_ == PH_REPS(18) - 1) SEAM(18); }
    if (IN(19)) for (int rep_ = 0; rep_ < PH_REPS(19); ++rep_) { PH_PTRS();
        pg8::Gemm g{H, (const bf16*)(ws + WS_W_FFIN1), NLAT, 2 * FH, DM, DM}; pg8::StaticOrder S; S.init(NLAT, 2 * FH, F.G, bx);
        pg8::EpiGate<1> E{(bf16*)(ws + WS_A2), FH};
        pg8::gemm_phase<pg8::EpiGate<1>, pg8::StaticOrder, true, true>(F.lds, g, S, E); if (rep_ == PH_REPS(19) - 1) SEAM(19); }
    if (IN(20)) for (int rep_ = 0; rep_ < PH_REPS(20); ++rep_) { PH_PTRS();
        pg8::Gemm g{(const bf16*)(ws + WS_A2), (const bf16*)(ws + WS_W_FFOUT1), NLAT, DM, FH, FH}; pg8::StaticOrder S; S.init(NLAT, DM, F.G, bx);
        bf16* X3 = X + (size_t)NTOK * DM;
        pg8::EpiRes<true, false> E{X3, X3, F.out, F.out, mod1 + 5 * DM};
        pg8::gemm_phase<pg8::EpiRes<true, false>, pg8::StaticOrder, true, true>(F.lds, g, S, E); }
#undef IN
#undef SEAM
}

extern "C" void kernel_launch(void* const* d_in, const int* in_sizes, int n_in, void* d_out, int out_size, void* d_ws, size_t ws_size, hipStream_t stream) {
    static int grid = 0;
    if (grid == 0) {
        if (n_in != 29 || in_sizes[0] != NLAT * DM || out_size != NLAT * DM || ws_size < WS_END) {
            fprintf(stderr, "kernel_launch: unexpected shapes: n_in %d in0 %d out %d ws %zu (need >= %zu); nothing launched\n", n_in, n_in > 0 ? in_sizes[0] : -1, out_size, ws_size, (size_t)WS_END); grid = -1; return; }
        int dev = 0, cus = 0, per_cu = 0;
        if (hipGetDevice(&dev) != hipSuccess || hipDeviceGetAttribute(&cus, hipDeviceAttributeMultiprocessorCount, dev) != hipSuccess) { fprintf(stderr, "kernel_launch: device query failed\n"); grid = -1; return; }
        if (hipFuncSetAttribute((const void*)mk_fwd, hipFuncAttributeMaxDynamicSharedMemorySize, LDS_BYTES) != hipSuccess) { fprintf(stderr, "kernel_launch: hipFuncSetAttribute failed\n"); grid = -1; return; }
        if (hipOccupancyMaxActiveBlocksPerMultiprocessor(&per_cu, (const void*)mk_fwd, NWAVES * 64, LDS_BYTES) != hipSuccess || per_cu < 1) { fprintf(stderr, "kernel_launch: occupancy query failed (%d)\n", per_cu); (void)hipGetLastError(); per_cu = 1; }
        grid = cus * 1;
        fprintf(stderr, "kernel_launch: cus %d per_cu %d grid %d\n", cus, per_cu, grid);
    }
    if (grid < 0) return;
    if (hipMemsetAsync((char*)d_ws + WS_CTL, 0, CTL_ZERO_BYTES, stream) != hipSuccess) { fprintf(stderr, "kernel_launch: memset failed\n"); return; }
    Args a{};
    for (int i = 0; i < 29; ++i) a.in[i] = (const float*)d_in[i];
    a.out = (float*)d_out; a.ws = (unsigned char*)d_ws;
#if MK_MULTI
    for (int p = 0; p < NPHASE; ++p) { a.ph_lo = p; a.ph_hi = p + 1; hipLaunchKernelGGL(mk_fwd, dim3(grid), dim3(NWAVES * 64), LDS_BYTES, stream, a); }
#else
    a.ph_lo = 0; a.ph_hi = NPHASE;
    void* kargs[] = {&a};
    hipError_t e = hipLaunchCooperativeKernel((const void*)mk_fwd, dim3(grid), dim3(NWAVES * 64), kargs, LDS_BYTES, stream);
    if (e != hipSuccess) fprintf(stderr, "kernel_launch: cooperative launch failed: %s (grid %d)\n", hipGetErrorString(e), grid);
#endif
    const hipError_t le = hipPeekAtLastError();
    if (le != hipSuccess) fprintf(stderr, "kernel_launch: launch failed: %s\n", hipGetErrorName(le));
}
```
